# Optimizing an MI355X kernel written in HIP

```python
import math, functools
import jax, jax.numpy as jnp
from jax import lax
import numpy as np

D_MODEL = 1024
BATCH = 8
SEQ = 2048
DEPTH = 2
DEC_BATCH = 128
DEC_SEQ = 8
PAST_LEN = 16384
PAGE_SIZE = 128

N_META = 16
CHUNK = 64
EPS = 1e-6
CONV_W = 4
N_BRANCH = 3
ML_HEADS = 4
ML_DQK = D_MODEL // 8
ML_DV = D_MODEL // 4
ML_QK = ML_HEADS * ML_DQK
ML_V = ML_HEADS * ML_DV
LRU_W = D_MODEL
LRU_BLOCKS = 16
LRU_BD = LRU_W // LRU_BLOCKS
LRU_C = 8.0
SSD_HEADS = 16
SSD_P = D_MODEL // SSD_HEADS
SSD_INNER = SSD_HEADS * SSD_P
SSD_GROUPS = 4
SSD_N = 128
SSD_CONV_CH = SSD_INNER + 2 * SSD_GROUPS * SSD_N
IN_SPLITS = (ML_QK, ML_QK, ML_V, ML_HEADS, ML_HEADS, ML_V, ML_V,
             LRU_W, LRU_W,
             SSD_INNER, SSD_CONV_CH, SSD_HEADS,
             N_BRANCH * D_MODEL)
N_IN = 2 * ML_QK + 3 * ML_V + 2 * ML_HEADS + 2 * LRU_W + SSD_INNER + SSD_CONV_CH + SSD_HEADS + N_BRANCH * D_MODEL

kernel_name = 'hybrid_mlstm_rglru_ssd_decode_step'


def rmsnorm(x, g):
    xf = x.astype(jnp.float32)
    return xf * lax.rsqrt(jnp.mean(xf * xf, axis=-1, keepdims=True) + EPS) * g.astype(jnp.float32)


def split_cols(u):
    offs = np.cumsum((0,) + IN_SPLITS)
    return [u[..., int(offs[j]):int(offs[j + 1])] for j in range(len(IN_SPLITS))]


def _chunk(t):
    return math.gcd(t, CHUNK)


def causal_dwconv(x, buf, w, b):
    t = x.shape[1]
    xp = jnp.concatenate([buf, x], axis=1)
    y = b + xp[:, 0:t] * w[0]
    for j in range(1, CONV_W):
        y = y + xp[:, j:j + t] * w[j]
    return y, xp[:, -(CONV_W - 1):]


def _segmented(scan_fn, n_lead, seqs, state):
    if n_lead == 0:
        return scan_fn(*seqs, *state)
    out0, *state = scan_fn(*(s[:, :n_lead] for s in seqs), *state)
    out1, *state = scan_fn(*(s[:, n_lead:] for s in seqs), *state)
    return (jnp.concatenate([out0, out1], axis=1), *state)


def mlstm_scan(q, k, v, logi, logf, c0, n0, m0):
    bsz, t, h, _ = q.shape
    L = _chunk(t)
    nc = t // L

    def to_chunks(a):
        return jnp.moveaxis(a.reshape((bsz, nc, L) + a.shape[2:]), 1, 0)

    xs = tuple(to_chunks(a) for a in (q, k, v, logi, logf))
    causal = jnp.tril(jnp.ones((L, L), bool))[None, :, :, None]

    def step(carry, inp):
        c, n, m = carry
        qc, kc, vc, li, lf = inp
        b = jnp.cumsum(lf, axis=1)
        d = jnp.where(causal, b[:, :, None, :] - b[:, None, :, :] + li[:, None, :, :], -jnp.inf)
        inter = b + m[:, None, :]
        mt = jnp.maximum(inter, jnp.max(d, axis=2))
        s = jnp.einsum('bthd,bshd->btsh', qc, kc) * jnp.exp(d - mt[:, :, None, :])
        w_inter = jnp.exp(inter - mt)
        num = jnp.einsum('btsh,bshv->bthv', s, vc) + w_inter[..., None] * jnp.einsum('bthd,bhdv->bthv', qc, c)
        den = jnp.sum(s, axis=2) + w_inter * jnp.einsum('bthd,bhd->bth', qc, n)
        hout = num / jnp.maximum(jnp.abs(den), jnp.exp(-mt))[..., None]
        bl = b[:, -1]
        g = bl[:, None, :] - b + li
        m_new = jnp.maximum(bl + m, jnp.max(g, axis=1))
        ws = jnp.exp(g - m_new[:, None, :])
        wc = jnp.exp(bl + m - m_new)
        c_new = wc[..., None, None] * c + jnp.einsum('bsh,bshd,bshv->bhdv', ws, kc, vc)
        n_new = wc[..., None] * n + jnp.einsum('bsh,bshd->bhd', ws, kc)
        return (c_new, n_new, m_new), hout

    (c, n, m), hs = lax.scan(step, (c0, n0, m0), xs)
    hout = jnp.moveaxis(hs, 0, 1).reshape(bsz, t, h, v.shape[-1])
    return hout, c, n, m


def ssd_scan(xh, dt, bm, cm, s0, a):
    bsz, t, h, p = xh.shape
    g = bm.shape[2]
    e = h // g
    L = _chunk(t)
    nc = t // L

    def to_chunks(v):
        return jnp.moveaxis(v.reshape((bsz, nc, L) + v.shape[2:]), 1, 0)

    xs = tuple(to_chunks(v) for v in (xh.reshape(bsz, t, g, e, p), dt.reshape(bsz, t, g, e), bm, cm))
    causal = jnp.tril(jnp.ones((L, L), bool))[None, :, :, None, None]
    ag = a.reshape(g, e)

    def step(s, inp):
        xc, dtc, bc, cc = inp
        cum = jnp.cumsum(dtc * ag, axis=1)
        seg = jnp.where(causal, cum[:, :, None] - cum[:, None, :], -jnp.inf)
        w = jnp.einsum('btgn,bsgn->btsg', cc, bc)[..., None] * jnp.exp(seg) * dtc[:, None]
        y = jnp.einsum('btsge,bsgep->btgep', w, xc)
        y = y + jnp.einsum('btgn,bgepn->btgep', cc, s) * jnp.exp(cum)[..., None]
        cl = cum[:, -1]
        ws = jnp.exp(cl[:, None] - cum) * dtc
        s_new = jnp.exp(cl)[..., None, None] * s + jnp.einsum('bsge,bsgep,bsgn->bgepn', ws, xc, bc)
        return s_new, y

    s, ys = lax.scan(step, s0.reshape(bsz, g, e, p, -1), xs)
    y = jnp.moveaxis(ys, 0, 1).reshape(bsz, t, h, p)
    return y, s.reshape(bsz, h, p, -1)


def rglru(x, h0, w_a, b_a, w_x, b_x, lam):
    bsz, t, w = x.shape
    xb = x.reshape(bsz, t, LRU_BLOCKS, LRU_BD)
    r = jax.nn.sigmoid(jnp.einsum('btnd,nde->btne', xb, w_a).reshape(bsz, t, w) + b_a)
    i = jax.nn.sigmoid(jnp.einsum('btnd,nde->btne', xb, w_x).reshape(bsz, t, w) + b_x)
    log_a = -LRU_C * r * jax.nn.softplus(-lam)
    a = jnp.exp(log_a)
    u = jnp.sqrt(-jnp.expm1(2.0 * log_a)) * (i * x)
    u = u.at[:, 0].add(a[:, 0] * h0)

    def comb(l, rr):
        a1, b1 = l
        a2, b2 = rr
        return a1 * a2, a2 * b1 + b2

    _, hs = lax.associative_scan(comb, (a, u), axis=1)
    return hs, hs[:, -1]


def mixer_layer(x, n_lead, st, w_in, norm_g, ml_f_bias, ml_norm_g, lru_conv_w, lru_conv_b,
                lru_w_a, lru_b_a, lru_w_x, lru_b_x, lru_lambda, ssd_conv_w, ssd_conv_b,
                ssd_dt_bias, ssd_a_log, ssd_d, ssd_norm_g, w_br_ml, w_br_lru, w_br_ssd, w_out):
    c0, n0, m0, hl0, cl0, hs0, cs0 = (s.astype(jnp.float32) for s in st)
    bsz, t, _ = x.shape
    u = jnp.einsum('btd,de->bte', rmsnorm(x, norm_g), w_in)
    (ml_q, ml_k, ml_v, ml_i, ml_f, ml_o, ml_z, lru_x, lru_z,
     ssd_z, ssd_xbc, ssd_dt, gates) = split_cols(u)

    q = ml_q.reshape(bsz, t, ML_HEADS, ML_DQK)
    k = ml_k.reshape(bsz, t, ML_HEADS, ML_DQK) * (ML_DQK ** -0.5)
    v = ml_v.reshape(bsz, t, ML_HEADS, ML_DV)
    logf = jax.nn.log_sigmoid(ml_f + ml_f_bias)
    h_ml, c1, n1, m1 = _segmented(mlstm_scan, n_lead, (q, k, v, ml_i, logf), (c0, n0, m0))
    y_ml = rmsnorm(h_ml, ml_norm_g).reshape(bsz, t, ML_V) * jax.nn.sigmoid(ml_o) * jax.nn.silu(ml_z)

    xc, cl1 = causal_dwconv(lru_x, cl0, lru_conv_w, lru_conv_b)
    h_lru, hl1 = rglru(xc, hl0, lru_w_a, lru_b_a, lru_w_x, lru_b_x, lru_lambda)
    y_lru = h_lru * jax.nn.silu(lru_z)

    xbc, cs1 = causal_dwconv(ssd_xbc, cs0, ssd_conv_w, ssd_conv_b)
    xbc = jax.nn.silu(xbc)
    xs = xbc[..., :SSD_INNER].reshape(bsz, t, SSD_HEADS, SSD_P)
    bm = xbc[..., SSD_INNER:SSD_INNER + SSD_GROUPS * SSD_N].reshape(bsz, t, SSD_GROUPS, SSD_N)
    cm = xbc[..., SSD_INNER + SSD_GROUPS * SSD_N:].reshape(bsz, t, SSD_GROUPS, SSD_N)
    dt = jax.nn.softplus(ssd_dt + ssd_dt_bias)
    a = -jnp.exp(ssd_a_log.astype(jnp.float32))
    y_s, hs1 = _segmented(functools.partial(ssd_scan, a=a), n_lead, (xs, dt, bm, cm), (hs0,))
    y_s = (y_s + ssd_d[:, None] * xs).reshape(bsz, t, SSD_INNER) * jax.nn.silu(ssd_z)
    y_ssd = rmsnorm(y_s, ssd_norm_g)

    gt = jax.nn.sigmoid(gates).reshape(bsz, t, N_BRANCH, D_MODEL)
    merged = (gt[:, :, 0] * jnp.einsum('btw,wd->btd', y_ml, w_br_ml)
              + gt[:, :, 1] * jnp.einsum('btw,wd->btd', y_lru, w_br_lru)
              + gt[:, :, 2] * jnp.einsum('btw,wd->btd', y_ssd, w_br_ssd))
    out = jnp.einsum('btd,de->bte', merged, w_out)
    x_new = (x.astype(jnp.float32) + out).astype(x.dtype)
    return x_new, (c1, n1, m1, hl1, cl1, hs1, cs1)


def run_trunk(x, n_lead, states, layer_params, final_norm_g):
    new = []
    for l in range(DEPTH):
        x, st = mixer_layer(x, n_lead, tuple(s[l] for s in states), *(p[l] for p in layer_params))
        new.append(st)
    y = rmsnorm(x, final_norm_g).astype(x.dtype)
    stacked = tuple(jnp.stack([new[l][j] for l in range(DEPTH)]) for j in range(len(states)))
    return y, stacked


def setup_inputs(seed: int = 0) -> dict:
    key = jax.random.key(seed)
    ks = iter(jax.random.split(key, 48))

    def nrm(shape, scale):
        return scale * jax.random.normal(next(ks), shape, jnp.float32)

    def uni(shape, lo, hi):
        return jax.random.uniform(next(ks), shape, jnp.float32, lo, hi)

    x_prompt = nrm((BATCH, SEQ, D_MODEL), 1.0)
    x_sample = nrm((DEC_BATCH, DEC_SEQ, D_MODEL), 1.0)
    state_mlstm_c = nrm((DEPTH, DEC_BATCH, ML_HEADS, ML_DQK, ML_DV), 0.1)
    state_mlstm_n = nrm((DEPTH, DEC_BATCH, ML_HEADS, ML_DQK), 0.1)
    state_mlstm_m = nrm((DEPTH, DEC_BATCH, ML_HEADS), 0.5)
    state_rglru_h = nrm((DEPTH, DEC_BATCH, LRU_W), 0.5)
    state_rglru_conv = nrm((DEPTH, DEC_BATCH, CONV_W - 1, LRU_W), 1.0)
    state_ssd_h = nrm((DEPTH, DEC_BATCH, SSD_HEADS, SSD_P, SSD_N), 0.1)
    state_ssd_conv = nrm((DEPTH, DEC_BATCH, CONV_W - 1, SSD_CONV_CH), 1.0)
    meta_tokens = nrm((N_META, D_MODEL), 1.0)
    w_in = nrm((DEPTH, D_MODEL, N_IN), D_MODEL ** -0.5)
    norm_g = 1.0 + nrm((DEPTH, D_MODEL), 0.02)
    ml_f_bias = jnp.linspace(3.0, 6.0, ML_HEADS, dtype=jnp.float32)[None] + nrm((DEPTH, ML_HEADS), 0.1)
    ml_norm_g = 1.0 + nrm((DEPTH, ML_HEADS, ML_DV), 0.02)
    lru_conv_w = nrm((DEPTH, CONV_W, LRU_W), CONV_W ** -0.5)
    lru_conv_b = nrm((DEPTH, LRU_W), 0.02)
    lru_w_a = nrm((DEPTH, LRU_BLOCKS, LRU_BD, LRU_BD), LRU_BD ** -0.5)
    lru_b_a = nrm((DEPTH, LRU_W), 0.02)
    lru_w_x = nrm((DEPTH, LRU_BLOCKS, LRU_BD, LRU_BD), LRU_BD ** -0.5)
    lru_b_x = nrm((DEPTH, LRU_W), 0.02)
    a_c = uni((DEPTH, LRU_W), 0.9, 0.999) ** (1.0 / LRU_C)
    lru_lambda = jnp.log(a_c) - jnp.log1p(-a_c)
    ssd_conv_w = nrm((DEPTH, CONV_W, SSD_CONV_CH), CONV_W ** -0.5)
    ssd_conv_b = nrm((DEPTH, SSD_CONV_CH), 0.02)
    dt0 = jnp.exp(uni((DEPTH, SSD_HEADS), math.log(1e-3), math.log(1e-1)))
    ssd_dt_bias = dt0 + jnp.log(-jnp.expm1(-dt0))
    ssd_a_log = jnp.log(uni((DEPTH, SSD_HEADS), 1.0, 16.0))
    ssd_d = 1.0 + nrm((DEPTH, SSD_HEADS), 0.1)
    ssd_norm_g = 1.0 + nrm((DEPTH, SSD_INNER), 0.02)
    w_br_ml = nrm((DEPTH, ML_V, D_MODEL), ML_V ** -0.5)
    w_br_lru = nrm((DEPTH, LRU_W, D_MODEL), LRU_W ** -0.5)
    w_br_ssd = nrm((DEPTH, SSD_INNER, D_MODEL), SSD_INNER ** -0.5)
    w_out = nrm((DEPTH, D_MODEL, D_MODEL), D_MODEL ** -0.5)
    final_norm_g = 1.0 + nrm((D_MODEL,), 0.02)
    return {'x_prompt': x_prompt, 'x_sample': x_sample,
            'state_mlstm_c': state_mlstm_c, 'state_mlstm_n': state_mlstm_n, 'state_mlstm_m': state_mlstm_m,
            'state_rglru_h': state_rglru_h, 'state_rglru_conv': state_rglru_conv,
            'state_ssd_h': state_ssd_h, 'state_ssd_conv': state_ssd_conv,
            'meta_tokens': meta_tokens, 'w_in': w_in, 'norm_g': norm_g, 'ml_f_bias': ml_f_bias,
            'ml_norm_g': ml_norm_g, 'lru_conv_w': lru_conv_w, 'lru_conv_b': lru_conv_b,
            'lru_w_a': lru_w_a, 'lru_b_a': lru_b_a, 'lru_w_x': lru_w_x, 'lru_b_x': lru_b_x,
            'lru_lambda': lru_lambda, 'ssd_conv_w': ssd_conv_w, 'ssd_conv_b': ssd_conv_b,
            'ssd_dt_bias': ssd_dt_bias, 'ssd_a_log': ssd_a_log, 'ssd_d': ssd_d, 'ssd_norm_g': ssd_norm_g,
            'w_br_ml': w_br_ml, 'w_br_lru': w_br_lru, 'w_br_ssd': w_br_ssd, 'w_out': w_out,
            'final_norm_g': final_norm_g}


def reference(x_prompt, x_sample, state_mlstm_c, state_mlstm_n, state_mlstm_m, state_rglru_h,
              state_rglru_conv, state_ssd_h, state_ssd_conv, meta_tokens, w_in, norm_g, ml_f_bias,
              ml_norm_g, lru_conv_w, lru_conv_b, lru_w_a, lru_b_a, lru_w_x, lru_b_x, lru_lambda,
              ssd_conv_w, ssd_conv_b, ssd_dt_bias, ssd_a_log, ssd_d, ssd_norm_g,
              w_br_ml, w_br_lru, w_br_ssd, w_out, final_norm_g):
    layer_params = (w_in, norm_g, ml_f_bias, ml_norm_g, lru_conv_w, lru_conv_b, lru_w_a, lru_b_a,
                    lru_w_x, lru_b_x, lru_lambda, ssd_conv_w, ssd_conv_b, ssd_dt_bias, ssd_a_log,
                    ssd_d, ssd_norm_g, w_br_ml, w_br_lru, w_br_ssd, w_out)
    sample_states = (state_mlstm_c, state_mlstm_n, state_mlstm_m, state_rglru_h, state_rglru_conv,
                     state_ssd_h, state_ssd_conv)
    bp = x_prompt.shape[0]
    meta = jnp.broadcast_to(meta_tokens.astype(x_prompt.dtype)[None], (bp, N_META, D_MODEL))
    xp = jnp.concatenate([meta, x_prompt], axis=1)
    zero_states = tuple(jnp.zeros((DEPTH, bp) + s.shape[2:], jnp.float32) for s in sample_states)
    yp, (p_c, p_n, p_m, p_hl, p_cl, p_hs, p_cs) = run_trunk(xp, N_META, zero_states, layer_params, final_norm_g)
    y_prompt = yp[:, N_META:]
    y_sample, (s_c, s_n, s_m, s_hl, s_cl, s_hs, s_cs) = run_trunk(x_sample, 0, sample_states, layer_params, final_norm_g)
    return (y_prompt, y_sample, p_c, p_n, p_m, p_hl, p_cl, p_hs, p_cs, s_c, s_n, s_m, s_hl, s_cl, s_hs, s_cs)
```

```cpp
#include <hip/hip_runtime.h>
#include <cstdio>
#include <cstdint>

#ifndef MK_N_LAUNCHES
#define MK_N_LAUNCHES 1
#endif

namespace pg8 {
#define PG8_LAS __attribute__((address_space(3)))
typedef unsigned short bf16_t;
typedef short bf16x8 __attribute__((ext_vector_type(8)));
typedef float f32x4 __attribute__((ext_vector_type(4)));
typedef unsigned u32x4 __attribute__((ext_vector_type(4)));
typedef unsigned u32x2 __attribute__((ext_vector_type(2)));
constexpr int BM = 256, BK = 64, HALF = 128, HTB = HALF * BK * 2, STAGE_BYTES = 8 * HTB, NXCD = 8, WGM = 8;

__host__ __device__ __forceinline__ int lds_byte(int r, int c) { const int st = (r >> 4) * 2 + (c >> 5), rr = r & 15, cc = c & 31, ob = rr * 64 + cc * 2; return st * 1024 + (ob ^ (((ob >> 9) & 1) << 5)); }
__host__ __device__ __forceinline__ void stage_rc(int b, int& R, int& C) { const int st = b / 1024, sb = b % 1024, swz = sb ^ (((sb >> 9) & 1) << 5); R = (st >> 1) * 16 + swz / 64; C = (st & 1) * 32 + (swz % 64) / 2; }
__host__ __device__ __forceinline__ int perm32(int rho) { const int n = rho >> 4, i = rho & 15; return 8 * (i >> 2) + 4 * n + (i & 3); }

struct Unit { int pm, pn, z; };
struct Gemm { const char* A; int lda; const char* Bt; int K; };

__device__ __forceinline__ unsigned cvt_pk_bf16(float lo, float hi) { unsigned r; asm volatile("v_cvt_pk_bf16_f32 %0, %1, %2" : "=v"(r) : "v"(lo), "v"(hi)); return r; }

struct TileOrder {
    int nM, nN, nwg, G, c;
    __device__ void init(int nM_, int nN_, int G_, int c_) { nM = nM_; nN = nN_; nwg = nM * nN; G = G_; c = c_; }
    __device__ bool tile(int i, int& pm, int& pn) const {
        const long L = (long)i * G + c; if (L >= nwg) return false;
        int wgid = (int)L; { const int q = nwg / NXCD, r = nwg % NXCD, xcd = wgid % NXCD, off = wgid / NXCD; wgid = (xcd < r ? xcd * (q + 1) : r * (q + 1) + (xcd - r) * q) + off; }
        const int nig = WGM * nN, gid = wgid / nig, fm = gid * WGM, gsz = (nM - fm) < WGM ? (nM - fm) : WGM;
        pm = fm + ((wgid % nig) % gsz); pn = (wgid % nig) / gsz; return true;
    }
};

template <class Epi, class Sched>
__device__ __forceinline__ void gemm_phase(PG8_LAS unsigned char* lds, const Gemm g, const Sched& S, const Epi& E) {
    const int tid = threadIdx.x, wid = __builtin_amdgcn_readfirstlane(tid >> 6), lane = tid & 63, wr = wid >> 2, wc = wid & 3, fr = lane & 15, fq = lane >> 4;
    const int K = g.K, nt = K / BK, lda = g.lda;
    unsigned voffA[2], voffB[2];
#pragma unroll
    for (int i = 0; i < 2; ++i) { int R, C; stage_rc(tid * 16 + i * 8192, R, C); const int Rb = Epi::PERM ? ((R & ~31) + perm32(R & 31)) : R;
        voffA[i] = (unsigned)(R * lda + C) * 2u; voffB[i] = (unsigned)(Rb * K + C) * 2u; }
    const size_t kstep = (size_t)(BK * 2);
    const size_t hstepA = (size_t)HALF * lda * 2, hstepB = (size_t)HALF * K * 2;
    const unsigned ldsw = (unsigned)wid * 1024u;
    const int aoff = lds_byte(wr * 64 + fr, fq * 8), boff = lds_byte(wc * 32 + fr, fq * 8);
#define PG8_SA(b, h) (((b) * 2 + (h)) * HTB)
#define PG8_SB(b, h) ((4 + (b) * 2 + (h)) * HTB)
#define PG8_STAGE(bufoff, gbase, voff) do { _Pragma("unroll") for (int _i = 0; _i < 2; ++_i) \
        __builtin_amdgcn_global_load_lds((const unsigned*)((const char*)(gbase) + (voff)[_i]), (PG8_LAS unsigned*)(lds + (bufoff) + ldsw + _i * 8192), 16, 0, 0); } while (0)
#define PG8_LDA(dst, b, h) do { _Pragma("unroll") for (int m = 0; m < 4; ++m) _Pragma("unroll") for (int k = 0; k < 2; ++k) dst[m][k] = *(const PG8_LAS bf16x8*)(lds + PG8_SA(b, h) + aoff + m * 2048 + k * 1024); } while (0)
#define PG8_LDB(dst, b, h) do { _Pragma("unroll") for (int n = 0; n < 2; ++n) _Pragma("unroll") for (int k = 0; k < 2; ++k) dst[n][k] = *(const PG8_LAS bf16x8*)(lds + PG8_SB(b, h) + boff + n * 2048 + k * 1024); } while (0)
#define PG8_MMA(ai, bj, At, Bt) do { __builtin_amdgcn_s_setprio(1); _Pragma("unroll") for (int m = 0; m < 4; ++m) _Pragma("unroll") for (int n = 0; n < 2; ++n) _Pragma("unroll") for (int k = 0; k < 2; ++k) \
        acc[ai][bj][m][n] = __builtin_amdgcn_mfma_f32_16x16x32_bf16(Bt[n][k], At[m][k], acc[ai][bj][m][n], 0, 0, 0); __builtin_amdgcn_s_setprio(0); } while (0)
#define PG8_WAIT_V(n) asm volatile("s_waitcnt vmcnt(" #n ")" ::: "memory")
#define PG8_WAIT_L(n) asm volatile("s_waitcnt lgkmcnt(" #n ")" ::: "memory")
#define PG8_BAR __builtin_amdgcn_s_barrier()
#define PG8_SCHED __builtin_amdgcn_sched_barrier(0)
    Unit cur, nxt; int ui = 0;
    if (!S.next(0, cur)) return;
    f32x4 acc[2][2][4][2];
#pragma unroll
    for (int a = 0; a < 2; ++a)
#pragma unroll
        for (int b = 0; b < 2; ++b)
#pragma unroll
            for (int m = 0; m < 4; ++m)
#pragma unroll
                for (int n = 0; n < 2; ++n) acc[a][b][m][n] = (f32x4){0.f, 0.f, 0.f, 0.f};
    bf16x8 At[4][2], B0[2][2], B1[2][2];
    const char* cA = g.A + S.a_off(cur); const char* cB = g.Bt + S.b_off(cur);
    {
        PG8_STAGE(PG8_SB(0, 0), cB, voffB); PG8_STAGE(PG8_SB(0, 1), cB + hstepB, voffB); PG8_STAGE(PG8_SA(0, 0), cA, voffA); PG8_STAGE(PG8_SA(0, 1), cA + hstepA, voffA);
        if (wr == 1) PG8_BAR;
        PG8_WAIT_V(2); PG8_BAR;
        PG8_STAGE(PG8_SB(1, 0), cB + kstep, voffB); PG8_STAGE(PG8_SA(1, 0), cA + kstep, voffA); PG8_STAGE(PG8_SB(1, 1), cB + hstepB + kstep, voffB);
        PG8_WAIT_V(6); PG8_BAR;
    }
    for (;;) {
        const bool has_next = S.next(ui + 1, nxt);
        const char* nA = has_next ? g.A + S.a_off(nxt) : cA; const char* nB = has_next ? g.Bt + S.b_off(nxt) : cB;
        for (int t = 0; t < nt; t += 2) {
            const bool last = (t == nt - 2);
            const char* a1 = cA + (size_t)(t + 1) * kstep;
            const char* a2 = last ? nA : cA + (size_t)(t + 2) * kstep; const char* b2 = last ? nB : cB + (size_t)(t + 2) * kstep;
            const char* a3 = a2 + kstep; const char* b3 = b2 + kstep;
            PG8_LDB(B0, 0, 0); PG8_LDB(B1, 0, 1); PG8_SCHED; PG8_LDA(At, 0, 0); PG8_STAGE(PG8_SA(1, 1), a1 + hstepA, voffA);
            PG8_WAIT_V(8); PG8_WAIT_L(0); PG8_BAR; PG8_MMA(0, 0, At, B0); PG8_MMA(0, 1, At, B1); PG8_BAR; PG8_SCHED;
            PG8_LDA(At, 0, 1); PG8_STAGE(PG8_SB(0, 0), b2, voffB); PG8_STAGE(PG8_SB(0, 1), b2 + hstepB, voffB); PG8_STAGE(PG8_SA(0, 0), a2, voffA);
            PG8_WAIT_V(8); PG8_WAIT_L(0); PG8_BAR; PG8_MMA(1, 0, At, B0); PG8_MMA(1, 1, At, B1); PG8_BAR; PG8_SCHED;
            PG8_LDB(B0, 1, 0); PG8_LDB(B1, 1, 1); PG8_SCHED; PG8_LDA(At, 1, 0); PG8_STAGE(PG8_SA(0, 1), a2 + hstepA, voffA);
            PG8_WAIT_V(8); PG8_WAIT_L(0); PG8_BAR; PG8_MMA(0, 0, At, B0); PG8_MMA(0, 1, At, B1); PG8_BAR; PG8_SCHED;
            PG8_LDA(At, 1, 1); PG8_STAGE(PG8_SB(1, 0), b3, voffB); PG8_STAGE(PG8_SB(1, 1), b3 + hstepB, voffB); PG8_STAGE(PG8_SA(1, 0), a3, voffA);
            PG8_WAIT_V(8); PG8_WAIT_L(0); PG8_BAR; PG8_MMA(1, 0, At, B0); PG8_MMA(1, 1, At, B1); PG8_BAR; PG8_SCHED;
        }
        if (wr == 0) PG8_BAR;
        E(acc, cur, wr, wc, fr, fq);
        if (!has_next) break;
#pragma unroll
        for (int a = 0; a < 2; ++a)
#pragma unroll
            for (int b = 0; b < 2; ++b)
#pragma unroll
                for (int m = 0; m < 4; ++m)
#pragma unroll
                    for (int n = 0; n < 2; ++n) acc[a][b][m][n] = (f32x4){0.f, 0.f, 0.f, 0.f};
        cur = nxt; cA = nA; cB = nB; ++ui;
        if (wr == 1) PG8_BAR;
    }
    PG8_WAIT_V(0);
    PG8_BAR;
#undef PG8_SA
#undef PG8_SB
#undef PG8_STAGE
#undef PG8_LDA
#undef PG8_LDB
#undef PG8_MMA
#undef PG8_WAIT_V
#undef PG8_WAIT_L
#undef PG8_BAR
#undef PG8_SCHED
}
}

constexpr int NWAVES = 8, NTHR = 512;
constexpr int N_LAUNCHES = MK_N_LAUNCHES;
constexpr int N_PHASES = 13;
constexpr int DM = 1024, BATCH = 8, SEQ = 2048, DECB = 128, DECS = 8, NMETA = 16;
constexpr int PT = SEQ + NMETA;
constexpr int ROW0 = 48;
constexpr int PROWS = BATCH * PT;
constexpr int SROW0 = ROW0 + PROWS;
constexpr int SROWS = DECB * DECS;
constexpr int RTOK = SROW0 + SROWS;
constexpr int R = 17664;
constexpr int NCH = 33;
constexpr int NIN = 12312, NBIG = 12288;
constexpr int C_Q = 0, C_K = 512, C_V = 1024, C_O = 2048, C_Z = 3072, C_LX = 4096, C_LZ = 5120, C_SZ = 6144, C_XBC = 7168, C_G = 9216;
constexpr int C_TMP = 2048;
constexpr int USMW = 32;
constexpr float EPS = 1e-6f;

constexpr size_t MiB = 1u << 20;
constexpr size_t WS_CTL = 0, CTL_ZERO_BYTES = 1 * MiB;
constexpr size_t WS_U = 1 * MiB;
constexpr size_t WS_USM = WS_U + (size_t)R * NBIG * 2;
constexpr size_t WS_XN = WS_USM + (size_t)R * USMW * 4;
constexpr size_t WS_WIN = WS_XN + (size_t)R * DM * 2;
constexpr size_t WS_WBR = WS_WIN + (size_t)NBIG * DM * 2;
constexpr size_t WS_WOUT = WS_WBR + (size_t)6 * DM * DM * 2;
constexpr size_t WS_WLRU = WS_WOUT + (size_t)2 * DM * DM * 2;
constexpr size_t WS_XAUX = WS_WLRU + (size_t)2 * 2 * 16 * 64 * 64 * 2;
constexpr size_t WS_END = WS_XAUX + (size_t)256 * DM * 4;
static_assert(WS_END <= 512 * MiB, "d_ws map must fit 512 MiB");
static_assert(WS_USM % 256 == 0 && WS_XN % 256 == 0 && WS_WIN % 256 == 0 && WS_WBR % 256 == 0 && WS_WLRU % 256 == 0 && WS_XAUX % 256 == 0, "alignment");
constexpr int CW_TMO = 0, CW_CODE = 1, CW_BAR = 4096;
constexpr size_t O_YP = 0, O_YS = O_YP + (size_t)BATCH * SEQ * DM, O_PC = O_YS + (size_t)SROWS * DM, O_PN = O_PC + (size_t)2 * 8 * 4 * 128 * 256,
    O_PM = O_PN + 2 * 8 * 4 * 128, O_PHL = O_PM + 2 * 8 * 4, O_PCL = O_PHL + 2 * 8 * 1024, O_PHS = O_PCL + 2 * 8 * 3 * 1024, O_PCS = O_PHS + (size_t)2 * 8 * 16 * 64 * 128,
    O_SC = O_PCS + 2 * 8 * 3 * 2048, O_SN = O_SC + (size_t)2 * 128 * 4 * 128 * 256, O_SM = O_SN + 2 * 128 * 4 * 128, O_SHL = O_SM + 2 * 128 * 4, O_SCL = O_SHL + 2 * 128 * 1024,
    O_SHS = O_SCL + 2 * 128 * 3 * 1024, O_SCS = O_SHS + (size_t)2 * 128 * 16 * 64 * 128, O_END = O_SCS + 2 * 128 * 3 * 2048;

constexpr int RING_BYTES = 131072;
constexpr int LDSCTL_OFF = 144 * 1024, MISC_OFF = LDSCTL_OFF + 320;
constexpr int LDS_BYTES = 147456 + 1024;
static_assert(MISC_OFF + 128 <= LDS_BYTES, "LDS map");

#define GAS __attribute__((address_space(1)))
#define LAS __attribute__((address_space(3)))
typedef unsigned short bf16;
typedef unsigned v4u __attribute__((ext_vector_type(4)));
typedef unsigned v2u __attribute__((ext_vector_type(2)));
typedef float f32x4 __attribute__((ext_vector_type(4)));
typedef float f32x2 __attribute__((ext_vector_type(2)));
typedef short bf16x8 __attribute__((ext_vector_type(8)));
typedef GAS unsigned gu32;
#define RLX_AGENT __ATOMIC_RELAXED, __HIP_MEMORY_SCOPE_AGENT
#define LDS_WAIT() asm volatile("s_waitcnt lgkmcnt(0)" ::: "memory")
#define VM_WAIT() asm volatile("s_waitcnt vmcnt(0)" ::: "memory")
__device__ __forceinline__ unsigned f2bf(float f) { unsigned u = __builtin_bit_cast(unsigned, f); return (u + 0x7fffu + ((u >> 16) & 1u)) >> 16; }
__device__ __forceinline__ unsigned pk2(float lo, float hi) { return f2bf(lo) | (f2bf(hi) << 16); }
__device__ __forceinline__ float bf2f(unsigned short b) { return __builtin_bit_cast(float, (unsigned)b << 16); }
__device__ __forceinline__ float bflo(unsigned w) { return __builtin_bit_cast(float, w << 16); }
__device__ __forceinline__ float bfhi(unsigned w) { return __builtin_bit_cast(float, w & 0xffff0000u); }
__device__ __forceinline__ float sigmoidf_(float x) { return 1.f / (1.f + __expf(-x)); }
__device__ __forceinline__ float siluf_(float x) { return x / (1.f + __expf(-x)); }
__device__ __forceinline__ float softplusf_(float x) { return fmaxf(x, 0.f) + log1pf(__expf(-fabsf(x))); }
__device__ __forceinline__ float logsigmoidf_(float x) { return fminf(x, 0.f) - log1pf(__expf(-fabsf(x))); }
__device__ __forceinline__ float wave_sum(float v) {
#pragma unroll
    for (int o = 1; o < 64; o <<= 1) v += __shfl_xor(v, o);
    return v;
}

#define XB_TMO      128
#define XB_XCNT(j)  (256  + 64 * (j))
#define XB_XSUB(j)  (1280 + 64 * (j))
#define XB_XGEN(j)  (2304 + 64 * (j))
#define XB_TOP      3328
#define XB_TOPGEN   3392
#define XCD_BAR_WORDS 3456
#define XB_SPIN_CAP (1u << 22)
__device__ __forceinline__ unsigned xb_ld(unsigned* p)              { return __hip_atomic_load(p, __ATOMIC_RELAXED, __HIP_MEMORY_SCOPE_AGENT); }
__device__ __forceinline__ unsigned xb_add(unsigned* p, unsigned v) { return __hip_atomic_fetch_add(p, v, __ATOMIC_RELAXED, __HIP_MEMORY_SCOPE_AGENT); }
__device__ __forceinline__ unsigned xb_xcc_id() { return (unsigned)__builtin_amdgcn_s_getreg((3 << 11) | 20) & 0xFu; }
#define XB_SPIN(cond, bar) do { unsigned _sp = 0; while (cond) { __builtin_amdgcn_s_sleep(1); \
    if ((++_sp & 255u) == 0u) { if (xb_ld(&(bar)[XB_TMO])) break; if (_sp > XB_SPIN_CAP) { atomicAdd(&(bar)[XB_TMO], 1u); break; } } } } while (0)
struct XcdBarrier { unsigned* bar; unsigned x; volatile LAS unsigned* st; };
__device__ __forceinline__ XcdBarrier xcd_barrier_post(unsigned* bar, volatile LAS unsigned* st) {
    XcdBarrier b; b.bar = bar; b.x = xb_xcc_id(); b.st = st;
    if (threadIdx.x == 0) (void)xb_add(&bar[XB_XCNT(b.x)], 1u);
    return b;
}
__device__ __forceinline__ void xcd_barrier_complete(unsigned* bar, unsigned x, unsigned& nloc, unsigned& nx) {
    const unsigned G = gridDim.x * gridDim.y * gridDim.z;
    unsigned sum, cnt, mine, sp = 0u;
    for (;;) {
        sum = 0u; cnt = 0u; mine = 0u;
#pragma unroll
        for (unsigned j = 0; j < 16; ++j) { const unsigned c = xb_ld(&bar[XB_XCNT(j)]); sum += c; cnt += (c > 0u) ? 1u : 0u; mine = (j == x) ? c : mine; }
        if (sum == G) break;
        __builtin_amdgcn_s_sleep(1);
        if ((++sp & 255u) == 0u) { if (xb_ld(&bar[XB_TMO])) break; if (sp > XB_SPIN_CAP) { atomicAdd(&bar[XB_TMO], 1u); break; } }
    }
    nloc = mine > 0u ? mine : 1u; nx = cnt > 0u ? cnt : 1u;
}
__device__ __forceinline__ void xcd_barrier(const XcdBarrier& b) {
    asm volatile("s_waitcnt vmcnt(0)" ::: "memory");
    __syncthreads();
    if (threadIdx.x == 0) {
        unsigned* bar = b.bar;
        __builtin_amdgcn_s_waitcnt(0);
        unsigned nloc = b.st[0], nx = b.st[1];
        if (nloc == 0u) { xcd_barrier_complete(bar, b.x, nloc, nx); b.st[0] = nloc; b.st[1] = nx; }
        const unsigned old = xb_add(&bar[XB_XSUB(b.x)], 1u);
        const unsigned gen = old / nloc;
        if (old + 1u == (gen + 1u) * nloc) {
            __builtin_amdgcn_fence(__ATOMIC_RELEASE, "agent");
            asm volatile("s_waitcnt vmcnt(0)" ::: "memory");
            const unsigned og = xb_add(&bar[XB_TOP], 1u);
            const unsigned tg = og / nx;
            if (og + 1u == (tg + 1u) * nx) xb_add(&bar[XB_TOPGEN], 1u);
            else XB_SPIN(xb_ld(&bar[XB_TOPGEN]) == tg, bar);
            __builtin_amdgcn_fence(__ATOMIC_ACQUIRE, "agent");
            xb_add(&bar[XB_XGEN(b.x)], 1u);
            asm volatile("s_waitcnt vmcnt(0)" ::: "memory");
        } else {
            XB_SPIN(xb_ld(&bar[XB_XGEN(b.x)]) == gen, bar);
            __builtin_amdgcn_fence(__ATOMIC_ACQUIRE, "agent");
            asm volatile("s_waitcnt vmcnt(0)" ::: "memory");
        }
    }
    __syncthreads();
}

struct Args { const float* in[32]; float* out; unsigned char* ws; int ph_lo, ph_hi, li, pad; };
struct Frame {
    LAS unsigned char* lds;
    volatile LAS unsigned* MISC;
    gu32* ctl;
    int tid, lane, wave, vcu, G;
    float* out; unsigned char* ws;
    bf16 *U, *XN, *WIN, *WBR, *WOUT, *WLRU; float *USM, *XAUX;
};
enum { I_XP = 0, I_XS, I_SC, I_SN, I_SM, I_SHL, I_SCL, I_SHS, I_SCS, I_META, I_WIN, I_NORMG, I_FBIAS, I_MLNG, I_LCW, I_LCB, I_LWA, I_LBA, I_LWX, I_LBX, I_LLAM,
       I_SCW, I_SCB, I_SDTB, I_SALOG, I_SD, I_SNG, I_WBML, I_WBLRU, I_WBSSD, I_WOUT, I_FNG };

constexpr int PTR_OFF = LDSCTL_OFF + 512;
__device__ __forceinline__ const float* inp(const Frame& F, int i) {
    const volatile LAS unsigned* t = (const volatile LAS unsigned*)(F.lds + PTR_OFF) + 2 * i;
    const unsigned lo = __builtin_amdgcn_readfirstlane(t[0]), hi = __builtin_amdgcn_readfirstlane(t[1]);
    return (const float*)(((unsigned long long)hi << 32) | lo);
}
__device__ __forceinline__ const float* x0_row(const Frame& a, int row) {
    if (row < ROW0 || row >= RTOK) return nullptr;
    if (row >= SROW0) return inp(a, I_XS) + (size_t)(row - SROW0) * DM;
    const int p = row - ROW0, b = p / PT, t = p - b * PT;
    if (t < NMETA) return inp(a, I_META) + (size_t)t * DM;
    return inp(a, I_XP) + ((size_t)b * SEQ + (t - NMETA)) * DM;
}
__device__ __forceinline__ float* x1_row(float* out, float* xaux, int row) {
    if (row < ROW0) return xaux + (size_t)row * DM;
    if (row >= RTOK) return xaux + (size_t)(176 + row - RTOK) * DM;
    if (row >= SROW0) return out + O_YS + (size_t)(row - SROW0) * DM;
    const int p = row - ROW0, b = p / PT, t = p - b * PT;
    if (t < NMETA) return xaux + (size_t)(48 + b * NMETA + t) * DM;
    return out + O_YP + ((size_t)b * SEQ + (t - NMETA)) * DM;
}

__device__ __forceinline__ void transpose_item(const float* W, int ldw, int K, bf16* WT, int k0, int csrc0, int orow0, float scale, LAS float* scr, int lane) {
#pragma unroll 8
    for (int i = 0; i < 32; ++i) { const int kk = 2 * i + (lane >> 5); scr[kk * 33 + (lane & 31)] = W[(size_t)(k0 + kk) * ldw + csrc0 + (lane & 31)]; }
    LDS_WAIT(); asm volatile("" ::: "memory");
    const int c = lane & 7;
#pragma unroll
    for (int j = 0; j < 4; ++j) { const int n = (lane >> 3) + 8 * j; const LAS float* s = scr + (8 * c) * 33 + n;
        v4u o; o.x = pk2(s[0 * 33] * scale, s[1 * 33] * scale); o.y = pk2(s[2 * 33] * scale, s[3 * 33] * scale); o.z = pk2(s[4 * 33] * scale, s[5 * 33] * scale); o.w = pk2(s[6 * 33] * scale, s[7 * 33] * scale);
        *(GAS v4u*)(WT + (size_t)(orow0 + n) * K + k0 + 8 * c) = o; }
    LDS_WAIT(); asm volatile("" ::: "memory");
}
__device__ __forceinline__ void win_item(Frame& F, int layer, int it, LAS float* scr) {
    const int kb = it / 384, nb = it % 384, n0 = nb * 32;
    const int csrc = n0 + (n0 >= 2048 ? 8 : 0) + (n0 >= 9216 ? 16 : 0);
    const float scale = (n0 >= C_K && n0 < C_V) ? 0.08838834764831845f : 1.0f;
    transpose_item(inp(F, I_WIN) + (size_t)layer * DM * NIN, NIN, DM, F.WIN, kb * 64, csrc, n0, scale, scr, F.lane);
}
constexpr int WIN_ITEMS = 16 * 384;
constexpr int WSQ_ITEMS = 2 * 4 * 512, WLRU_ITEMS = 2 * 2 * 16 * 2;
__device__ __forceinline__ void wsq_item(Frame& F, int it, LAS float* scr) {
    const int layer = it / 2048, r = it % 2048, m = r / 512, q = r % 512, kb = q / 32, nb = q % 32;
    const float* W = inp(F, m == 0 ? I_WBML : m == 1 ? I_WBLRU : m == 2 ? I_WBSSD : I_WOUT) + (size_t)layer * DM * DM;
    bf16* WT = (m < 3) ? F.WBR + ((size_t)layer * 3 + m) * DM * DM : F.WOUT + (size_t)layer * DM * DM;
    transpose_item(W, DM, DM, WT, kb * 64, nb * 32, nb * 32, 1.0f, scr, F.lane);
}
__device__ __forceinline__ void wlru_item(Frame& F, int it, LAS float* scr) {
    const int nb = it & 1, blk = (it >> 1) & 15, ax = (it >> 5) & 1, layer = it >> 6;
    const float* W = inp(F, ax ? I_LWX : I_LWA) + ((size_t)layer * 16 + blk) * 64 * 64;
    bf16* WT = F.WLRU + (((size_t)layer * 2 + ax) * 16 + blk) * 64 * 64;
    transpose_item(W, 64, 64, WT, 0, nb * 32, nb * 32, 1.0f, scr, F.lane);
}
constexpr int WSM_LD = 1028;
__device__ __forceinline__ void norm_rows(Frame& F, int layer) {
    LAS float* Wsm = (LAS float*)F.lds;
    const float* W = inp(F, I_WIN) + (size_t)layer * DM * NIN;
    for (int idx = F.tid; idx < 24 * DM; idx += NTHR) { const int k = idx / 24, c = idx - k * 24; const int col = (c < 8) ? 2048 + c : 9224 + (c - 8);
        Wsm[c * WSM_LD + k] = W[(size_t)k * NIN + col]; }
    __syncthreads();
    const float* g = inp(F, I_NORMG) + layer * DM;
    f32x4 gv[4];
#pragma unroll
    for (int j = 0; j < 4; ++j) gv[j] = *(const f32x4*)(g + 4 * F.lane + 256 * j);
    const int gw = F.vcu * NWAVES + F.wave, NGW = F.G * NWAVES;
    for (int row = gw; row < R; row += NGW) {
        const float* xr = (layer == 0) ? x0_row(F, row) : (const float*)x1_row(F.out, F.XAUX, row);
        GAS unsigned long long* o8 = (GAS unsigned long long*)(F.XN + (size_t)row * DM) + F.lane;
        float* us = F.USM + (size_t)row * USMW;
        if (xr == nullptr || row < ROW0 || row >= RTOK) {
#pragma unroll
            for (int j = 0; j < 4; ++j) o8[64 * j] = 0ull;
            if (F.lane < USMW) us[F.lane] = 0.f;
            continue;
        }
        f32x4 v[4]; float s = 0.f;
#pragma unroll
        for (int j = 0; j < 4; ++j) { v[j] = *(const f32x4*)(xr + 4 * F.lane + 256 * j); s += (v[j].x * v[j].x + v[j].y * v[j].y) + (v[j].z * v[j].z + v[j].w * v[j].w); }
        const float rstd = 1.0f / sqrtf(wave_sum(s) * (1.f / DM) + EPS);
#pragma unroll
        for (int j = 0; j < 4; ++j) { v[j] = v[j] * rstd * gv[j];
            o8[64 * j] = (unsigned long long)pk2(v[j].x, v[j].y) | ((unsigned long long)pk2(v[j].z, v[j].w) << 32); }
        float mine = 0.f;
#pragma unroll 4
        for (int c = 0; c < 24; ++c) {
            float d = 0.f;
#pragma unroll
            for (int j = 0; j < 4; ++j) { const f32x4 w = *(const LAS f32x4*)(Wsm + c * WSM_LD + 4 * F.lane + 256 * j); d += (v[j].x * w.x + v[j].y * w.y) + (v[j].z * w.z + v[j].w * w.w); }
            d = wave_sum(d);
            mine = (F.lane == c) ? d : mine;
        }
        if (F.lane < USMW) us[F.lane] = (F.lane < 24) ? mine : 0.f;
    }
}

struct SchedIn {
    pg8::TileOrder T;
    __device__ __forceinline__ bool next(int i, pg8::Unit& u) const { u.z = 0; return T.tile(i, u.pm, u.pn); }
    __device__ __forceinline__ size_t a_off(const pg8::Unit& u) const { return (size_t)u.pm * 256 * DM * 2; }
    __device__ __forceinline__ size_t b_off(const pg8::Unit& u) const { return (size_t)u.pn * 256 * DM * 2; }
};
struct EpiU {
    static constexpr bool PERM = true;
    bf16* U;
    __device__ __forceinline__ void operator()(const f32x4 (&acc)[2][2][4][2], const pg8::Unit& u, int wr, int wc, int fr, int fq) const {
        const int row0 = u.pm * 256 + wr * 64 + fr, col0 = u.pn * 256 + wc * 32 + 8 * fq;
#pragma unroll
        for (int ai = 0; ai < 2; ++ai)
#pragma unroll
            for (int m = 0; m < 4; ++m) { bf16* rowp = U + (size_t)(row0 + ai * 128 + m * 16) * NBIG + col0;
#pragma unroll
                for (int bj = 0; bj < 2; ++bj) { const f32x4 v0 = acc[ai][bj][m][0], v1 = acc[ai][bj][m][1];
                    v4u w; w.x = pg8::cvt_pk_bf16(v0[0], v0[1]); w.y = pg8::cvt_pk_bf16(v0[2], v0[3]); w.z = pg8::cvt_pk_bf16(v1[0], v1[1]); w.w = pg8::cvt_pk_bf16(v1[2], v1[3]);
                    *(v4u*)(rowp + bj * 128) = w; } }
    }
};
struct SchedBr {
    pg8::TileOrder T; int layer;
    __device__ __forceinline__ bool next(int i, pg8::Unit& u) const { u.z = i % 3; return T.tile(i / 3, u.pm, u.pn); }
    __device__ __forceinline__ size_t a_off(const pg8::Unit& u) const { const int col = (u.z == 0) ? C_V : (u.z == 1) ? C_LZ : C_SZ; return ((size_t)u.pm * 256 * NBIG + col) * 2; }
    __device__ __forceinline__ size_t b_off(const pg8::Unit& u) const { return ((size_t)(layer * 3 + u.z) * DM * DM + (size_t)u.pn * 256 * DM) * 2; }
};
struct EpiBr {
    static constexpr bool PERM = false;
    bf16* U; bf16* MG;
    __device__ __forceinline__ void operator()(const f32x4 (&acc)[2][2][4][2], const pg8::Unit& u, int wr, int wc, int fr, int fq) const {
        const int row0 = u.pm * 256 + wr * 64 + fr, col0 = u.pn * 256 + wc * 32 + 4 * fq;
#pragma unroll
        for (int ai = 0; ai < 2; ++ai)
#pragma unroll
            for (int m = 0; m < 4; ++m) { const int row = row0 + ai * 128 + m * 16; bf16* ur = U + (size_t)row * NBIG;
#pragma unroll
                for (int bj = 0; bj < 2; ++bj)
#pragma unroll
                    for (int n = 0; n < 2; ++n) { const int col = col0 + bj * 128 + n * 16;
                        const v2u gw = *(const v2u*)(ur + C_G + u.z * DM + col);
                        f32x4 v = acc[ai][bj][m][n];
                        v[0] *= sigmoidf_(bflo(gw.x)); v[1] *= sigmoidf_(bfhi(gw.x)); v[2] *= sigmoidf_(bflo(gw.y)); v[3] *= sigmoidf_(bfhi(gw.y));
                        float* tp = (float*)(ur + C_TMP) + col;
                        if (u.z == 0) *(f32x4*)tp = v;
                        else if (u.z == 1) *(f32x4*)tp = *(const f32x4*)tp + v;
                        else { v = *(const f32x4*)tp + v; v2u o; o.x = pg8::cvt_pk_bf16(v[0], v[1]); o.y = pg8::cvt_pk_bf16(v[2], v[3]); *(v2u*)(MG + (size_t)row * DM + col) = o; } } }
    }
};
struct SchedOut {
    pg8::TileOrder T; int layer;
    __device__ __forceinline__ bool next(int i, pg8::Unit& u) const { u.z = 0; return T.tile(i, u.pm, u.pn); }
    __device__ __forceinline__ size_t a_off(const pg8::Unit& u) const { return (size_t)u.pm * 256 * DM * 2; }
    __device__ __forceinline__ size_t b_off(const pg8::Unit& u) const { return ((size_t)layer * DM * DM + (size_t)u.pn * 256 * DM) * 2; }
};
struct EpiOut {
    static constexpr bool PERM = false;
    const Frame* a; float* out; float* xaux; int layer;
    __device__ __forceinline__ void operator()(const f32x4 (&acc)[2][2][4][2], const pg8::Unit& u, int wr, int wc, int fr, int fq) const {
        const int row0 = u.pm * 256 + wr * 64 + fr, col0 = u.pn * 256 + wc * 32 + 4 * fq;
#pragma unroll
        for (int ai = 0; ai < 2; ++ai)
#pragma unroll
            for (int m = 0; m < 4; ++m) { const int row = row0 + ai * 128 + m * 16;
                float* dst = x1_row(out, xaux, row); const float* src = (layer == 0) ? x0_row(*a, row) : (const float*)dst;
#pragma unroll
                for (int bj = 0; bj < 2; ++bj)
#pragma unroll
                    for (int n = 0; n < 2; ++n) { const int col = col0 + bj * 128 + n * 16;
                        f32x4 v = acc[ai][bj][m][n]; if (src) v = v + *(const f32x4*)(src + col);
                        *(f32x4*)(dst + col) = v; } }
    }
};

__device__ __forceinline__ void conv_state_out(Frame& F, int layer) {
    const int gt = F.vcu * NTHR + F.tid, NG = F.G * NTHR;
    for (int i = gt; i < BATCH * 3 * 1024; i += NG) { const int ch = i & 1023, j = (i >> 10) % 3, b = i / 3072; const int row = ROW0 + b * PT + (PT - 3) + j;
        F.out[O_PCL + ((size_t)(layer * BATCH + b) * 3 + j) * 1024 + ch] = bf2f(F.U[(size_t)row * NBIG + C_LX + ch]); }
    for (int i = gt; i < BATCH * 3 * 2048; i += NG) { const int ch = i & 2047, j = (i >> 11) % 3, b = i / 6144; const int row = ROW0 + b * PT + (PT - 3) + j;
        F.out[O_PCS + ((size_t)(layer * BATCH + b) * 3 + j) * 2048 + ch] = bf2f(F.U[(size_t)row * NBIG + C_XBC + ch]); }
    for (int i = gt; i < DECB * 3 * 1024; i += NG) { const int ch = i & 1023, j = (i >> 10) % 3, b = i / 3072; const int row = SROW0 + b * DECS + (DECS - 3) + j;
        F.out[O_SCL + ((size_t)(layer * DECB + b) * 3 + j) * 1024 + ch] = bf2f(F.U[(size_t)row * NBIG + C_LX + ch]); }
    for (int i = gt; i < DECB * 3 * 2048; i += NG) { const int ch = i & 2047, j = (i >> 11) % 3, b = i / 6144; const int row = SROW0 + b * DECS + (DECS - 3) + j;
        F.out[O_SCS + ((size_t)(layer * DECB + b) * 3 + j) * 2048 + ch] = bf2f(F.U[(size_t)row * NBIG + C_XBC + ch]); }
}

#define MFMA16(a, b, c) __builtin_amdgcn_mfma_f32_16x16x32_bf16(a, b, c, 0, 0, 0)
__device__ __forceinline__ bf16x8 ldfrag(const LAS unsigned char* base, int ld, int row, int k) { return *(const LAS bf16x8*)(base + (row * ld + k) * 2); }
__device__ __forceinline__ float scan_add(float x, int lane) {
#pragma unroll
    for (int o = 1; o < 64; o <<= 1) { const float t = __shfl_up(x, o); if (lane >= o) x += t; }
    return x;
}
__device__ __forceinline__ float scan_max(float x, int lane) {
#pragma unroll
    for (int o = 1; o < 64; o <<= 1) { const float t = __shfl_up(x, o); if (lane >= o) x = fmaxf(x, t); }
    return x;
}
constexpr int L_QS = 0, L_KS = 17408, L_KT = 34816, L_VT = 53248, L_PS = 57856, L_CT = 67072, L_FA = 84480, L_VX = 88576, L_CW = 96768;
constexpr int LDQ = 136, LDT = 72;
constexpr int FA_COLV = 0, FA_ROWV = 64, FA_INTER = 128, FA_KS = 192, FA_CLAMP = 256, FA_DENS = 320, FA_QN = 384, FA_NVEC = 448, FA_SC = 576;

template <bool IS_ML>
__device__ __forceinline__ void chunk_scan_item(Frame& F, int layer, int item) {
    const int tid = F.tid, lane = F.lane, w = F.wave, fr = lane & 15, fq = lane >> 4;
    LAS unsigned char* lds = F.lds;
    LAS float* fa = (LAS float*)(lds + L_FA);
    LAS float* vx = (LAS float*)(lds + L_VX);
    LAS float* cw = (LAS float*)(lds + L_CW);
    int b, hd, sl;
    if (IS_ML) { b = item >> 5; hd = (item >> 3) & 3; sl = item & 7; } else { b = item >> 5; hd = (item >> 1) & 15; sl = item & 1; }
    const int grp = hd >> 2;
    const int seq0 = ROW0 + b * PT;
    const int qcol = IS_ML ? C_Q + hd * 128 : C_XBC + 1536 + grp * 128;
    const int kcol = IS_ML ? C_K + hd * 128 : C_XBC + 1024 + grp * 128;
    const int vcol = IS_ML ? C_V + hd * 256 + sl * 32 : C_XBC + hd * 64 + sl * 32;
    const int zcol = C_SZ + hd * 64 + sl * 32;
    float fbias = 0.f, dtb = 0.f, aneg = 0.f, dskip = 0.f;
    if (IS_ML) fbias = inp(F, I_FBIAS)[layer * 4 + hd];
    else { dtb = inp(F, I_SDTB)[layer * 16 + hd]; aneg = -__expf(inp(F, I_SALOG)[layer * 16 + hd]); dskip = inp(F, I_SD)[layer * 16 + hd]; }
    if (!IS_ML) {
        const float* W = inp(F, I_SCW) + (size_t)layer * 4 * 2048; const float* Bv = inp(F, I_SCB) + (size_t)layer * 2048;
        for (int i = tid; i < 5 * 288; i += NTHR) { const int j = i / 288, c = i - j * 288;
            const int ch = (c < 128) ? 1536 + grp * 128 + c : (c < 256) ? 1024 + grp * 128 + (c - 128) : hd * 64 + sl * 32 + (c - 256);
            cw[i] = (j < 4) ? W[j * 2048 + ch] : Bv[ch]; }
    }
    for (int i = tid; i < 2 * 32 * LDQ / 2; i += NTHR) ((LAS unsigned*)(lds + L_CT))[i] = 0u;
    if (tid < 128) fa[FA_NVEC + tid] = 0.f;
    if (tid == 0) { fa[FA_SC + 1] = 0.f; }
    f32x4 st0 = {0.f, 0.f, 0.f, 0.f}, st1 = {0.f, 0.f, 0.f, 0.f};
    __syncthreads();
    for (int j = 0; j < NCH; ++j) {
        const int r0 = b * PT + 64 * j;
        const int cur = j & 1;
        if (IS_ML) {
#pragma unroll
            for (int i = 0; i < 2; ++i) { const int pc = tid + 512 * i, row = pc >> 4, c16 = pc & 15;
                const bf16* src = F.U + (size_t)(r0 + row) * NBIG;
                *(LAS v4u*)(lds + L_QS + (row * LDQ + c16 * 8) * 2) = *(const v4u*)(src + qcol + c16 * 8);
                *(LAS v4u*)(lds + L_KS + (row * LDQ + c16 * 8) * 2) = *(const v4u*)(src + kcol + c16 * 8); }
            if (tid < 256) { const int row = tid >> 2, c = tid & 3; const v4u v = *(const v4u*)(F.U + (size_t)(r0 + row) * NBIG + vcol + c * 8);
                LAS bf16* vt = (LAS bf16*)(lds + L_VT);
                vt[(c * 8 + 0) * LDT + row] = (bf16)(v.x & 0xffff); vt[(c * 8 + 1) * LDT + row] = (bf16)(v.x >> 16);
                vt[(c * 8 + 2) * LDT + row] = (bf16)(v.y & 0xffff); vt[(c * 8 + 3) * LDT + row] = (bf16)(v.y >> 16);
                vt[(c * 8 + 4) * LDT + row] = (bf16)(v.z & 0xffff); vt[(c * 8 + 5) * LDT + row] = (bf16)(v.z >> 16);
                vt[(c * 8 + 6) * LDT + row] = (bf16)(v.w & 0xffff); vt[(c * 8 + 7) * LDT + row] = (bf16)(v.w >> 16); }
        } else {
            {
                const int cg = tid & 31, seg = tid >> 5, c0 = cg * 8;
                const int gcol = (c0 < 128) ? qcol + c0 : kcol + (c0 - 128);
                float raw[7][8];
#pragma unroll
                for (int rr = 0; rr < 7; ++rr) { const int row = r0 + seg * 4 - 3 + rr; v4u v = {0u, 0u, 0u, 0u};
                    if (row >= seq0) v = *(const v4u*)(F.U + (size_t)row * NBIG + gcol);
                    raw[rr][0] = bflo(v.x); raw[rr][1] = bfhi(v.x); raw[rr][2] = bflo(v.y); raw[rr][3] = bfhi(v.y); raw[rr][4] = bflo(v.z); raw[rr][5] = bfhi(v.z); raw[rr][6] = bflo(v.w); raw[rr][7] = bfhi(v.w); }
                float wv[5][8];
#pragma unroll
                for (int jj = 0; jj < 5; ++jj)
#pragma unroll
                    for (int e = 0; e < 8; ++e) wv[jj][e] = cw[jj * 288 + c0 + e];
#pragma unroll
                for (int q = 0; q < 4; ++q) { float o[8];
#pragma unroll
                    for (int e = 0; e < 8; ++e) { float a = wv[4][e] + wv[0][e] * raw[q][e] + wv[1][e] * raw[q + 1][e] + wv[2][e] * raw[q + 2][e] + wv[3][e] * raw[q + 3][e]; o[e] = siluf_(a); }
                    v4u pk; pk.x = pk2(o[0], o[1]); pk.y = pk2(o[2], o[3]); pk.z = pk2(o[4], o[5]); pk.w = pk2(o[6], o[7]);
                    const int row = seg * 4 + q;
                    *(LAS v4u*)(lds + ((c0 < 128) ? L_QS + (row * LDQ + c0) * 2 : L_KS + (row * LDQ + (c0 - 128)) * 2)) = pk; }
            }
            if (tid < 64) {
                const int cg = tid & 3, seg = tid >> 2, c0 = cg * 8;
                float raw[7][8];
#pragma unroll
                for (int rr = 0; rr < 7; ++rr) { const int row = r0 + seg * 4 - 3 + rr; v4u v = {0u, 0u, 0u, 0u};
                    if (row >= seq0) v = *(const v4u*)(F.U + (size_t)row * NBIG + vcol + c0);
                    raw[rr][0] = bflo(v.x); raw[rr][1] = bfhi(v.x); raw[rr][2] = bflo(v.y); raw[rr][3] = bfhi(v.y); raw[rr][4] = bflo(v.z); raw[rr][5] = bfhi(v.z); raw[rr][6] = bflo(v.w); raw[rr][7] = bfhi(v.w); }
                LAS bf16* vt = (LAS bf16*)(lds + L_VT);
#pragma unroll
                for (int q = 0; q < 4; ++q) { const int row = seg * 4 + q;
#pragma unroll
                    for (int e = 0; e < 8; ++e) { const int c = 256 + c0 + e;
                        float a = cw[4 * 288 + c] + cw[c] * raw[q][e] + cw[288 + c] * raw[q + 1][e] + cw[2 * 288 + c] * raw[q + 2][e] + cw[3 * 288 + c] * raw[q + 3][e];
                        a = siluf_(a); vx[row * 32 + c0 + e] = a; vt[(c0 + e) * LDT + row] = (bf16)f2bf(a); } }
            }
        }
        if (w == 7) {
            const int row = r0 + lane; const bool valid = row >= seq0;
            const float* us = F.USM + (size_t)row * USMW;
            const float mprev = fa[FA_SC + 1];
            if (IS_ML) {
                const float li = valid ? us[hd] : -INFINITY;
                const float lf = valid ? logsigmoidf_(us[4 + hd] + fbias) : 0.f;
                const float bc = scan_add(lf, lane);
                const float c = li - bc;
                const float M = fmaxf(mprev, scan_max(c, lane));
                const float M63 = __shfl(M, 63), b63 = __shfl(bc, 63);
                fa[FA_COLV + lane] = c; fa[FA_ROWV + lane] = M; fa[FA_INTER + lane] = __expf(mprev - M); fa[FA_KS + lane] = __expf(c - M63);
                fa[FA_CLAMP + lane] = __expf(-(bc + M));
                if (lane == 0) { fa[FA_SC + 0] = __expf(mprev - M63); fa[FA_SC + 1] = b63 + M63; }
            } else {
                const float dt = valid ? softplusf_(us[8 + hd] + dtb) : 0.f;
                const float cum = scan_add(dt * aneg, lane);
                const float cl = __shfl(cum, 63);
                fa[FA_COLV + lane] = -cum + __logf(dt); fa[FA_ROWV + lane] = -cum; fa[FA_INTER + lane] = __expf(cum); fa[FA_KS + lane] = __expf(cl - cum) * dt;
                if (lane == 0) fa[FA_SC + 0] = __expf(cl);
            }
            fa[FA_DENS + lane] = 0.f; fa[FA_QN + lane] = 0.f;
        }
        __syncthreads();
        {
            const int tt = w >> 1;
#pragma unroll
            for (int h2 = 0; h2 < 2; ++h2) { const int stl = (w & 1) * 2 + h2;
                f32x4 acc = {0.f, 0.f, 0.f, 0.f};
#pragma unroll
                for (int kk = 0; kk < 4; ++kk) acc = MFMA16(ldfrag(lds + L_QS, LDQ, 16 * tt + fr, 32 * kk + 8 * fq), ldfrag(lds + L_KS, LDQ, 16 * stl + fr, 32 * kk + 8 * fq), acc);
                const int sidx = 16 * stl + fr; const float cv = fa[FA_COLV + sidx];
                LAS bf16* ps = (LAS bf16*)(lds + L_PS);
#pragma unroll
                for (int r = 0; r < 4; ++r) { const int t = 16 * tt + 4 * fq + r;
                    float val = (sidx <= t) ? acc[r] * __expf(cv - fa[FA_ROWV + t]) : 0.f;
                    ps[t * LDT + sidx] = (bf16)f2bf(val);
                    if (IS_ML) { val += __shfl_xor(val, 1); val += __shfl_xor(val, 2); val += __shfl_xor(val, 4); val += __shfl_xor(val, 8);
                        if (fr == 0) atomicAdd((float*)(fa + FA_DENS + t), val); } }
            }
            {
                const int sidx = tid & 63, dg = tid >> 6; const float sc = fa[FA_KS + sidx];
                const v4u k0 = *(const LAS v4u*)(lds + L_KS + (sidx * LDQ + dg * 16) * 2), k1 = *(const LAS v4u*)(lds + L_KS + (sidx * LDQ + dg * 16 + 8) * 2);
                LAS bf16* kt = (LAS bf16*)(lds + L_KT) + (dg * 16) * LDT + sidx;
                kt[0 * LDT] = (bf16)f2bf(bflo(k0.x) * sc); kt[1 * LDT] = (bf16)f2bf(bfhi(k0.x) * sc); kt[2 * LDT] = (bf16)f2bf(bflo(k0.y) * sc); kt[3 * LDT] = (bf16)f2bf(bfhi(k0.y) * sc);
                kt[4 * LDT] = (bf16)f2bf(bflo(k0.z) * sc); kt[5 * LDT] = (bf16)f2bf(bfhi(k0.z) * sc); kt[6 * LDT] = (bf16)f2bf(bflo(k0.w) * sc); kt[7 * LDT] = (bf16)f2bf(bfhi(k0.w) * sc);
                kt[8 * LDT] = (bf16)f2bf(bflo(k1.x) * sc); kt[9 * LDT] = (bf16)f2bf(bfhi(k1.x) * sc); kt[10 * LDT] = (bf16)f2bf(bflo(k1.y) * sc); kt[11 * LDT] = (bf16)f2bf(bfhi(k1.y) * sc);
                kt[12 * LDT] = (bf16)f2bf(bflo(k1.z) * sc); kt[13 * LDT] = (bf16)f2bf(bfhi(k1.z) * sc); kt[14 * LDT] = (bf16)f2bf(bflo(k1.w) * sc); kt[15 * LDT] = (bf16)f2bf(bfhi(k1.w) * sc);
            }
            if (IS_ML) {
                const int t = tid & 63, part = tid >> 6; float d = 0.f;
                const LAS bf16* q = (const LAS bf16*)(lds + L_QS) + t * LDQ + part * 16;
#pragma unroll
                for (int e = 0; e < 16; ++e) d += bf2f(q[e]) * fa[FA_NVEC + part * 16 + e];
                atomicAdd((float*)(fa + FA_QN + t), d);
            }
        }
        __syncthreads();
        {
            const int tt = w >> 1, vt2 = w & 1;
            f32x4 apv = {0.f, 0.f, 0.f, 0.f}, aqc = {0.f, 0.f, 0.f, 0.f};
#pragma unroll
            for (int kk = 0; kk < 2; ++kk) apv = MFMA16(ldfrag(lds + L_PS, LDT, 16 * tt + fr, 32 * kk + 8 * fq), ldfrag(lds + L_VT, LDT, 16 * vt2 + fr, 32 * kk + 8 * fq), apv);
#pragma unroll
            for (int kk = 0; kk < 4; ++kk) aqc = MFMA16(ldfrag(lds + L_QS, LDQ, 16 * tt + fr, 32 * kk + 8 * fq), ldfrag(lds + L_CT + cur * 32 * LDQ * 2, LDQ, 16 * vt2 + fr, 32 * kk + 8 * fq), aqc);
            const int vv = 16 * vt2 + fr;
#pragma unroll
            for (int r = 0; r < 4; ++r) { const int t = 16 * tt + 4 * fq + r; const int row = r0 + t;
                const float it = fa[FA_INTER + t]; const float num = apv[r] + it * aqc[r];
                if (row >= seq0) {
                    if (IS_ML) { const float den = fa[FA_DENS + t] + it * fa[FA_QN + t]; const float hv = num / fmaxf(fabsf(den), fa[FA_CLAMP + t]);
                        F.U[(size_t)row * NBIG + vcol + vv] = (bf16)f2bf(hv); }
                    else { bf16* zp = F.U + (size_t)row * NBIG + zcol + vv; const float z = bf2f(*zp); *zp = (bf16)f2bf((num + dskip * vx[t * 32 + vv]) * siluf_(z)); }
                } }
            const float wc = fa[FA_SC + 0];
            st0 = st0 * wc; st1 = st1 * wc;
#pragma unroll
            for (int kk = 0; kk < 2; ++kk) { const bf16x8 a = ldfrag(lds + L_KT, LDT, 16 * w + fr, 32 * kk + 8 * fq);
                st0 = MFMA16(a, ldfrag(lds + L_VT, LDT, fr, 32 * kk + 8 * fq), st0); st1 = MFMA16(a, ldfrag(lds + L_VT, LDT, 16 + fr, 32 * kk + 8 * fq), st1); }
            LAS unsigned char* ctn = lds + L_CT + (cur ^ 1) * 32 * LDQ * 2;
            { v2u o; o.x = pk2(st0[0], st0[1]); o.y = pk2(st0[2], st0[3]); *(LAS v2u*)(ctn + (fr * LDQ + 16 * w + 4 * fq) * 2) = o;
              o.x = pk2(st1[0], st1[1]); o.y = pk2(st1[2], st1[3]); *(LAS v2u*)(ctn + ((16 + fr) * LDQ + 16 * w + 4 * fq) * 2) = o; }
            if (IS_ML && tid < 128) { float nv = wc * fa[FA_NVEC + tid]; const LAS bf16* kp = (const LAS bf16*)(lds + L_KS) + tid;
#pragma unroll 8
                for (int sidx = 0; sidx < 64; ++sidx) nv += fa[FA_KS + sidx] * bf2f(kp[sidx * LDQ]);
                fa[FA_NVEC + tid] = nv; }
        }
        __syncthreads();
    }
    if (IS_ML) {
        float* pc = F.out + O_PC + (((size_t)(layer * BATCH + b) * 4 + hd) * 128) * 256 + sl * 32;
#pragma unroll
        for (int r = 0; r < 4; ++r) { const int d = 16 * w + 4 * fq + r; pc[(size_t)d * 256 + fr] = st0[r]; pc[(size_t)d * 256 + 16 + fr] = st1[r]; }
        if (sl == 0) { if (tid < 128) F.out[O_PN + ((size_t)(layer * BATCH + b) * 4 + hd) * 128 + tid] = fa[FA_NVEC + tid];
            if (tid == 0) F.out[O_PM + (layer * BATCH + b) * 4 + hd] = fa[FA_SC + 1]; }
    } else {
        float* ph = F.out + O_PHS + (((size_t)(layer * BATCH + b) * 16 + hd) * 64 + sl * 32) * 128;
        *(f32x4*)(ph + (size_t)fr * 128 + 16 * w + 4 * fq) = st0; *(f32x4*)(ph + (size_t)(16 + fr) * 128 + 16 * w + 4 * fq) = st1;
    }
    __syncthreads();
}
constexpr int L_XB = 0, L_XF = 9216, L_WA = 25600, L_WX = 30208, L_AA = 34816, L_UU = 43008, L_SA = 51200, L_SU = 53248, L_HP = 55296;
__device__ __forceinline__ void lru_prompt_item(Frame& F, int layer, int item) {
    const int tid = F.tid, lane = F.lane, w = F.wave, fr = lane & 15, fq = lane >> 4;
    LAS unsigned char* lds = F.lds;
    const int b = item >> 5, blk = (item >> 1) & 15, half = item & 1;
    const int seq0 = ROW0 + b * PT, ch0 = blk * 64;
    LAS float* xf = (LAS float*)(lds + L_XF); LAS float* aa = (LAS float*)(lds + L_AA); LAS float* uu = (LAS float*)(lds + L_UU);
    LAS float* sa = (LAS float*)(lds + L_SA); LAS float* su = (LAS float*)(lds + L_SU); LAS float* hp = (LAS float*)(lds + L_HP);
    {
        const int e = tid >> 3, c = tid & 7;
        const int ax = e >> 5, el = e & 31;
        const bf16* src = F.WLRU + ((((size_t)layer * 2 + ax) * 16 + blk) * 64 + half * 32 + el) * 64 + c * 8;
        *(LAS v4u*)(lds + (ax ? L_WX : L_WA) + (el * LDT + c * 8) * 2) = *(const v4u*)src;
    }
    if (tid < 64) hp[tid] = 0.f;
    const int cgc = tid & 7, crow = tid >> 3;
    float cwv[5][8];
    { const float* W = inp(F, I_LCW) + (size_t)layer * 4 * 1024 + ch0 + cgc * 8; const float* Bv = inp(F, I_LCB) + (size_t)layer * 1024 + ch0 + cgc * 8;
#pragma unroll
      for (int e = 0; e < 8; ++e) { cwv[0][e] = W[e]; cwv[1][e] = W[1024 + e]; cwv[2][e] = W[2048 + e]; cwv[3][e] = W[3072 + e]; cwv[4][e] = Bv[e]; } }
    const int ech = 16 * (w & 1) + fr, chn = ch0 + half * 32 + ech;
    const float ba = inp(F, I_LBA)[layer * 1024 + chn], bx = inp(F, I_LBX)[layer * 1024 + chn];
    const float spl = softplusf_(-inp(F, I_LLAM)[layer * 1024 + chn]);
    __syncthreads();
    for (int j = 0; j < NCH; ++j) {
        const int r0 = b * PT + 64 * j, cur = j & 1;
        {
            float acc[8];
#pragma unroll
            for (int e = 0; e < 8; ++e) acc[e] = cwv[4][e];
#pragma unroll
            for (int jj = 0; jj < 4; ++jj) { const int row = r0 + crow - 3 + jj; v4u v = {0u, 0u, 0u, 0u};
                if (row >= seq0) v = *(const v4u*)(F.U + (size_t)row * NBIG + C_LX + ch0 + cgc * 8);
                acc[0] += cwv[jj][0] * bflo(v.x); acc[1] += cwv[jj][1] * bfhi(v.x); acc[2] += cwv[jj][2] * bflo(v.y); acc[3] += cwv[jj][3] * bfhi(v.y);
                acc[4] += cwv[jj][4] * bflo(v.z); acc[5] += cwv[jj][5] * bfhi(v.z); acc[6] += cwv[jj][6] * bflo(v.w); acc[7] += cwv[jj][7] * bfhi(v.w); }
            v4u pk; pk.x = pk2(acc[0], acc[1]); pk.y = pk2(acc[2], acc[3]); pk.z = pk2(acc[4], acc[5]); pk.w = pk2(acc[6], acc[7]);
            *(LAS v4u*)(lds + L_XB + (crow * LDT + cgc * 8) * 2) = pk;
#pragma unroll
            for (int e = 0; e < 8; ++e) xf[crow * 64 + cgc * 8 + e] = acc[e];
        }
        __syncthreads();
        {
            const int tt = w >> 1;
            f32x4 ga = {0.f, 0.f, 0.f, 0.f}, gx = {0.f, 0.f, 0.f, 0.f};
#pragma unroll
            for (int kk = 0; kk < 2; ++kk) { const bf16x8 a = ldfrag(lds + L_XB, LDT, 16 * tt + fr, 32 * kk + 8 * fq);
                ga = MFMA16(a, ldfrag(lds + L_WA, LDT, 16 * (w & 1) + fr, 32 * kk + 8 * fq), ga); gx = MFMA16(a, ldfrag(lds + L_WX, LDT, 16 * (w & 1) + fr, 32 * kk + 8 * fq), gx); }
#pragma unroll
            for (int r = 0; r < 4; ++r) { const int t = 16 * tt + 4 * fq + r; const bool valid = (r0 + t) >= seq0;
                const float rg = sigmoidf_(ga[r] + ba), ig = sigmoidf_(gx[r] + bx);
                const float la = -8.0f * rg * spl; const float av = __expf(la);
                const float uv = sqrtf(fmaxf(1.0f - __expf(2.0f * la), 0.f)) * (ig * xf[t * 64 + half * 32 + ech]);
                aa[t * 32 + ech] = valid ? av : 1.0f; uu[t * 32 + ech] = valid ? uv : 0.f; }
        }
        __syncthreads();
        const int e = tid & 31, seg = tid >> 5;
        float a4[4], u4[4];
        { float A = 1.f, Ua = 0.f;
#pragma unroll
          for (int i = 0; i < 4; ++i) { a4[i] = aa[(seg * 4 + i) * 32 + e]; u4[i] = uu[(seg * 4 + i) * 32 + e]; A = a4[i] * A; Ua = a4[i] * Ua + u4[i]; }
          sa[seg * 32 + e] = A; su[seg * 32 + e] = Ua; }
        __syncthreads();
        { float h = hp[cur * 32 + e];
          for (int s2 = 0; s2 < seg; ++s2) h = sa[s2 * 32 + e] * h + su[s2 * 32 + e];
          const int chz = C_LZ + ch0 + half * 32 + e;
#pragma unroll
          for (int i = 0; i < 4; ++i) { h = a4[i] * h + u4[i]; const int row = r0 + seg * 4 + i;
              if (row >= seq0) { bf16* zp = F.U + (size_t)row * NBIG + chz; *zp = (bf16)f2bf(h * siluf_(bf2f(*zp))); } }
          if (seg == 15) hp[(cur ^ 1) * 32 + e] = h; }
        __syncthreads();
    }
    if (tid < 32) F.out[O_PHL + (size_t)(layer * BATCH + b) * 1024 + ch0 + half * 32 + tid] = hp[(NCH & 1) * 32 + tid];
    __syncthreads();
}

__device__ __forceinline__ float scan8_add(float x, int l8) {
#pragma unroll
    for (int o = 1; o < 8; o <<= 1) { const float t = __shfl_up(x, o, 8); if (l8 >= o) x += t; }
    return x;
}
__device__ __forceinline__ float scan8_max(float x, int l8) {
#pragma unroll
    for (int o = 1; o < 8; o <<= 1) { const float t = __shfl_up(x, o, 8); if (l8 >= o) x = fmaxf(x, t); }
    return x;
}
constexpr int S_QS = 0, S_KR = 4096, S_KW = 8192, S_NV = 12288, S_G = 12800, S_PM = 13312, S_QCS = 13568;
__device__ __forceinline__ void mlstm_sample_item(Frame& F, int layer, int item) {
    const int tid = F.tid, lane = F.lane, w = F.wave;
    const int b = item >> 2, hd = item & 3;
    LAS float* qs = (LAS float*)(F.lds + S_QS); LAS float* kr = (LAS float*)(F.lds + S_KR); LAS float* kw = (LAS float*)(F.lds + S_KW);
    LAS float* nv = (LAS float*)(F.lds + S_NV); LAS float* g = (LAS float*)(F.lds + S_G); LAS float* pm = (LAS float*)(F.lds + S_PM); LAS float* qcs = (LAS float*)(F.lds + S_QCS);
    const int row0 = SROW0 + b * DECS;
    const size_t sidx = (size_t)(layer * DECB + b) * 4 + hd;
#pragma unroll
    for (int i = 0; i < 2; ++i) { const int idx = tid + 512 * i, t = idx >> 7, d = idx & 127; const bf16* ur = F.U + (size_t)(row0 + t) * NBIG;
        qs[d * 8 + t] = bf2f(ur[C_Q + hd * 128 + d]); kr[d * 8 + t] = bf2f(ur[C_K + hd * 128 + d]); }
    if (tid < 128) nv[tid] = inp(F, I_SN)[sidx * 128 + tid];
    if (w == 7 && lane < 8) {
        const float* us = F.USM + (size_t)(row0 + lane) * USMW;
        const float m0 = inp(F, I_SM)[sidx];
        const float li = us[hd], lf = logsigmoidf_(us[4 + hd] + inp(F, I_FBIAS)[layer * 4 + hd]);
        const float bc = scan8_add(lf, lane), c = li - bc, M = fmaxf(m0, scan8_max(c, lane));
        const float M7 = __shfl(M, 7, 8), b7 = __shfl(bc, 7, 8);
        g[lane] = c; g[8 + lane] = M; g[16 + lane] = __expf(m0 - M); g[24 + lane] = __expf(c - M7); g[32 + lane] = __expf(-(bc + M));
        if (lane == 0) { g[56] = __expf(m0 - M7); g[57] = b7 + M7; }
    }
    __syncthreads();
    if (w == 0) {
        const int t = lane >> 3, sx = lane & 7; float d = 0.f;
        for (int dd = 0; dd < 128; ++dd) d += qs[dd * 8 + t] * kr[dd * 8 + sx];
        float val = (sx <= t) ? d * __expf(g[sx] - g[8 + t]) : 0.f;
        pm[t * 8 + sx] = val;
        val += __shfl_xor(val, 1); val += __shfl_xor(val, 2); val += __shfl_xor(val, 4);
        if (sx == 0) g[40 + t] = val;
    } else if (w == 1) {
        const int t = lane >> 3, part = lane & 7; float d = 0.f;
        for (int dd = part * 16; dd < part * 16 + 16; ++dd) d += qs[dd * 8 + t] * nv[dd];
        d += __shfl_xor(d, 1); d += __shfl_xor(d, 2); d += __shfl_xor(d, 4);
        if (part == 0) g[48 + t] = d;
    }
#pragma unroll
    for (int i = 0; i < 2; ++i) { const int idx = tid + 512 * i; kw[idx] = kr[idx] * g[24 + (idx & 7)]; }
    __syncthreads();
    const int v = tid & 255, dh = tid >> 8;
    float vv[8], qc[8];
#pragma unroll
    for (int t = 0; t < 8; ++t) { vv[t] = bf2f(F.U[(size_t)(row0 + t) * NBIG + C_V + hd * 256 + v]); qc[t] = 0.f; }
    {
        const float wc = g[56];
        const float* c0 = inp(F, I_SC) + sidx * 128 * 256 + v; float* c1 = F.out + O_SC + sidx * 128 * 256 + v;
#pragma unroll 4
        for (int d = dh * 64; d < dh * 64 + 64; ++d) {
            const float cval = c0[(size_t)d * 256];
            const f32x4 q0 = *(const LAS f32x4*)(qs + d * 8), q1 = *(const LAS f32x4*)(qs + d * 8 + 4), k0 = *(const LAS f32x4*)(kw + d * 8), k1 = *(const LAS f32x4*)(kw + d * 8 + 4);
            qc[0] += q0.x * cval; qc[1] += q0.y * cval; qc[2] += q0.z * cval; qc[3] += q0.w * cval; qc[4] += q1.x * cval; qc[5] += q1.y * cval; qc[6] += q1.z * cval; qc[7] += q1.w * cval;
            c1[(size_t)d * 256] = wc * cval + (k0.x * vv[0] + k0.y * vv[1] + k0.z * vv[2] + k0.w * vv[3]) + (k1.x * vv[4] + k1.y * vv[5] + k1.z * vv[6] + k1.w * vv[7]);
        }
    }
#pragma unroll
    for (int t = 0; t < 8; ++t) qcs[(dh * 8 + t) * 256 + v] = qc[t];
    __syncthreads();
#pragma unroll
    for (int i = 0; i < 4; ++i) { const int t = dh * 4 + i; const float QC = qcs[t * 256 + v] + qcs[(8 + t) * 256 + v];
        float pv = 0.f;
#pragma unroll
        for (int sx = 0; sx < 8; ++sx) pv += pm[t * 8 + sx] * vv[sx];
        const float it = g[16 + t]; const float num = pv + it * QC, den = g[40 + t] + it * g[48 + t];
        F.U[(size_t)(row0 + t) * NBIG + C_V + hd * 256 + v] = (bf16)f2bf(num / fmaxf(fabsf(den), g[32 + t])); }
    if (tid < 128) { float nn = g[56] * nv[tid];
#pragma unroll
        for (int sx = 0; sx < 8; ++sx) nn += kw[tid * 8 + sx];
        F.out[O_SN + sidx * 128 + tid] = nn; }
    if (tid == 0) F.out[O_SM + sidx] = g[57];
    __syncthreads();
}

constexpr int T_BC = 0, T_CC = 4096, T_G = 8192, T_XS = 8448, T_H = 10496, T_W = 10752, T_SL = 11008;
__device__ __forceinline__ float ssd_conv_sample(Frame& F, int layer, int b, int row0, int t, int ch, const float* W, const float* Bv) {
    float a = Bv[ch];
#pragma unroll
    for (int jj = 0; jj < 4; ++jj) { const int tp = t - 3 + jj;
        const float raw = (tp >= 0) ? bf2f(F.U[(size_t)(row0 + tp) * NBIG + C_XBC + ch]) : inp(F, I_SCS)[((size_t)(layer * DECB + b) * 3 + (3 + tp)) * 2048 + ch];
        a += W[jj * 2048 + ch] * raw; }
    return siluf_(a);
}
__device__ __forceinline__ void ssd_sample_item(Frame& F, int layer, int item) {
    const int tid = F.tid, lane = F.lane, w = F.wave;
    const int b = item >> 2, grp = item & 3, row0 = SROW0 + b * DECS;
    LAS float* Bc = (LAS float*)(F.lds + T_BC); LAS float* Cc = (LAS float*)(F.lds + T_CC); LAS float* G = (LAS float*)(F.lds + T_G);
    LAS float* xs = (LAS float*)(F.lds + T_XS); LAS float* hv = (LAS float*)(F.lds + T_H); LAS float* Wm = (LAS float*)(F.lds + T_W); LAS float* Sl = (LAS float*)(F.lds + T_SL);
    const float* W = inp(F, I_SCW) + (size_t)layer * 4 * 2048; const float* Bv = inp(F, I_SCB) + (size_t)layer * 2048;
#pragma unroll
    for (int i = 0; i < 4; ++i) { const int idx = tid + 512 * i, which = idx >> 10, t = (idx >> 7) & 7, n = idx & 127;
        const float val = ssd_conv_sample(F, layer, b, row0, t, 1024 + which * 512 + grp * 128 + n, W, Bv);
        if (which) Cc[t * 128 + n] = val; else Bc[t * 128 + n] = val; }
    __syncthreads();
    if (w == 0) { const int t = lane >> 3, sx = lane & 7; float d = 0.f;
        for (int n = 0; n < 128; ++n) d += Cc[t * 128 + n] * Bc[sx * 128 + n];
        G[t * 8 + sx] = d; }
    for (int e4 = 0; e4 < 4; ++e4) {
        const int hd = grp * 4 + e4;
        const size_t sidx = (size_t)(layer * DECB + b) * 16 + hd;
        { const int t = tid >> 6, pp = tid & 63; xs[t * 64 + pp] = ssd_conv_sample(F, layer, b, row0, t, hd * 64 + pp, W, Bv); }
        if (w == 7 && lane < 8) {
            const float dt = softplusf_(F.USM[(size_t)(row0 + lane) * USMW + 8 + hd] + inp(F, I_SDTB)[layer * 16 + hd]);
            const float aneg = -__expf(inp(F, I_SALOG)[layer * 16 + hd]);
            const float cum = scan8_add(dt * aneg, lane), cl = __shfl(cum, 7, 8);
            hv[lane] = cum; hv[8 + lane] = dt; hv[16 + lane] = __expf(cum); hv[24 + lane] = __expf(cl - cum) * dt;
            if (lane == 0) hv[32] = __expf(cl);
        }
        { const float* s0 = inp(F, I_SHS) + sidx * 64 * 128;
#pragma unroll
          for (int i = 0; i < 4; ++i) { const int idx4 = tid + 512 * i, pp = idx4 >> 5, n4 = idx4 & 31; const f32x4 v = *(const f32x4*)(s0 + pp * 128 + n4 * 4);
              LAS float* d = Sl + pp * 129 + n4 * 4; d[0] = v.x; d[1] = v.y; d[2] = v.z; d[3] = v.w; } }
        __syncthreads();
        if (w == 0) { const int t = lane >> 3, sx = lane & 7; Wm[t * 8 + sx] = (sx <= t) ? G[t * 8 + sx] * __expf(hv[t] - hv[sx]) * hv[8 + sx] : 0.f; }
        float ycs = 0.f;
        { const int t = tid >> 6, pp = tid & 63;
          for (int n = 0; n < 128; ++n) ycs += Cc[t * 128 + n] * Sl[pp * 129 + n]; }
        __syncthreads();
        { const int t = tid >> 6, pp = tid & 63; float y = hv[16 + t] * ycs;
#pragma unroll
          for (int sx = 0; sx < 8; ++sx) y += Wm[t * 8 + sx] * xs[sx * 64 + pp];
          bf16* zp = F.U + (size_t)(row0 + t) * NBIG + C_SZ + hd * 64 + pp;
          *zp = (bf16)f2bf((y + inp(F, I_SD)[layer * 16 + hd] * xs[t * 64 + pp]) * siluf_(bf2f(*zp))); }
        { const int n = tid & 127, pq = tid >> 7; const float wc = hv[32]; float bn[8];
#pragma unroll
          for (int sx = 0; sx < 8; ++sx) bn[sx] = Bc[sx * 128 + n] * hv[24 + sx];
          float* s1 = F.out + O_SHS + sidx * 64 * 128;
          for (int pp = pq * 16; pp < pq * 16 + 16; ++pp) { float sn = wc * Sl[pp * 129 + n];
#pragma unroll
              for (int sx = 0; sx < 8; ++sx) sn += xs[sx * 64 + pp] * bn[sx];
              s1[pp * 128 + n] = sn; } }
        __syncthreads();
    }
}

__device__ __forceinline__ void lru_sample_item(Frame& F, int layer, int item) {
    const int tid = F.tid;
    const int b = item >> 1, half = item & 1, ch = half * 512 + tid, row0 = SROW0 + b * DECS, blk = ch >> 6, e = ch & 63;
    LAS float* xcs = (LAS float*)F.lds;
    float xc[8];
    { const float* W = inp(F, I_LCW) + (size_t)layer * 4 * 1024; const float bias = inp(F, I_LCB)[layer * 1024 + ch];
      float raw[11];
#pragma unroll
      for (int i = 0; i < 3; ++i) raw[i] = inp(F, I_SCL)[((size_t)(layer * DECB + b) * 3 + i) * 1024 + ch];
#pragma unroll
      for (int t = 0; t < 8; ++t) raw[3 + t] = bf2f(F.U[(size_t)(row0 + t) * NBIG + C_LX + ch]);
      const float w0 = W[ch], w1 = W[1024 + ch], w2 = W[2048 + ch], w3 = W[3072 + ch];
#pragma unroll
      for (int t = 0; t < 8; ++t) { xc[t] = bias + w0 * raw[t] + w1 * raw[t + 1] + w2 * raw[t + 2] + w3 * raw[t + 3]; xcs[t * 512 + tid] = xc[t]; } }
    __syncthreads();
    float ra[8], rx[8];
#pragma unroll
    for (int t = 0; t < 8; ++t) { ra[t] = 0.f; rx[t] = 0.f; }
    { const float* wa = inp(F, I_LWA) + ((size_t)layer * 16 + blk) * 4096 + e; const float* wx = inp(F, I_LWX) + ((size_t)layer * 16 + blk) * 4096 + e;
      const int xb = (tid & ~63);
      for (int d = 0; d < 64; ++d) { const float a = wa[d * 64], x = wx[d * 64];
#pragma unroll
          for (int t = 0; t < 8; ++t) { const float xv = xcs[t * 512 + xb + d]; ra[t] += xv * a; rx[t] += xv * x; } } }
    const float ba = inp(F, I_LBA)[layer * 1024 + ch], bx = inp(F, I_LBX)[layer * 1024 + ch], spl = softplusf_(-inp(F, I_LLAM)[layer * 1024 + ch]);
    float h = inp(F, I_SHL)[(size_t)(layer * DECB + b) * 1024 + ch];
#pragma unroll
    for (int t = 0; t < 8; ++t) { const float rg = sigmoidf_(ra[t] + ba), ig = sigmoidf_(rx[t] + bx); const float la = -8.0f * rg * spl;
        h = __expf(la) * h + sqrtf(fmaxf(1.0f - __expf(2.0f * la), 0.f)) * (ig * xc[t]);
        bf16* zp = F.U + (size_t)(row0 + t) * NBIG + C_LZ + ch; *zp = (bf16)f2bf(h * siluf_(bf2f(*zp))); }
    F.out[O_SHL + (size_t)(layer * DECB + b) * 1024 + ch] = h;
    __syncthreads();
}

__device__ __forceinline__ void scan_phase(Frame& F, int layer) {
    for (int it = F.vcu; it < 256; it += F.G) chunk_scan_item<true>(F, layer, it);
    for (int it = F.vcu; it < 256; it += F.G) chunk_scan_item<false>(F, layer, it);
    for (int it = F.vcu; it < 256; it += F.G) lru_prompt_item(F, layer, it);
    for (int it = F.vcu; it < DECB * 4; it += F.G) mlstm_sample_item(F, layer, it);
    for (int it = F.vcu; it < DECB * 4; it += F.G) ssd_sample_item(F, layer, it);
    for (int it = F.vcu; it < DECB * 2; it += F.G) lru_sample_item(F, layer, it);
}
__device__ __forceinline__ void unpack16(const v4u a, const v4u b, float (&o)[16]) {
    o[0] = bflo(a.x); o[1] = bfhi(a.x); o[2] = bflo(a.y); o[3] = bfhi(a.y); o[4] = bflo(a.z); o[5] = bfhi(a.z); o[6] = bflo(a.w); o[7] = bfhi(a.w);
    o[8] = bflo(b.x); o[9] = bfhi(b.x); o[10] = bflo(b.y); o[11] = bfhi(b.y); o[12] = bflo(b.z); o[13] = bfhi(b.z); o[14] = bflo(b.w); o[15] = bfhi(b.w);
}
__device__ __forceinline__ void gate_phase(Frame& F, int layer) {
    const int lane = F.lane;
    float g1[16], g2[16];
    { const float* p1 = inp(F, I_MLNG) + layer * 1024 + 16 * lane; const float* p2 = inp(F, I_SNG) + layer * 1024 + 16 * lane;
#pragma unroll
      for (int e = 0; e < 16; ++e) { g1[e] = p1[e]; g2[e] = p2[e]; } }
    const int gw = F.vcu * NWAVES + F.wave, NGW = F.G * NWAVES;
    for (int row = ROW0 + gw; row < RTOK; row += NGW) {
        bf16* ur = F.U + (size_t)row * NBIG + 16 * lane;
        float h[16], o[16], z[16];
        unpack16(*(const v4u*)(ur + C_V), *(const v4u*)(ur + C_V + 8), h);
        unpack16(*(const v4u*)(ur + C_O), *(const v4u*)(ur + C_O + 8), o);
        unpack16(*(const v4u*)(ur + C_Z), *(const v4u*)(ur + C_Z + 8), z);
        float ss = 0.f;
#pragma unroll
        for (int e = 0; e < 16; ++e) ss += h[e] * h[e];
        ss += __shfl_xor(ss, 1); ss += __shfl_xor(ss, 2); ss += __shfl_xor(ss, 4); ss += __shfl_xor(ss, 8);
        const float rs = 1.0f / sqrtf(ss * (1.f / 256.f) + EPS);
#pragma unroll
        for (int e = 0; e < 16; ++e) h[e] = h[e] * rs * g1[e] * sigmoidf_(o[e]) * siluf_(z[e]);
        v4u a, b2; a.x = pk2(h[0], h[1]); a.y = pk2(h[2], h[3]); a.z = pk2(h[4], h[5]); a.w = pk2(h[6], h[7]); b2.x = pk2(h[8], h[9]); b2.y = pk2(h[10], h[11]); b2.z = pk2(h[12], h[13]); b2.w = pk2(h[14], h[15]);
        *(v4u*)(ur + C_V) = a; *(v4u*)(ur + C_V + 8) = b2;
        unpack16(*(const v4u*)(ur + C_SZ), *(const v4u*)(ur + C_SZ + 8), h);
        float s2 = 0.f;
#pragma unroll
        for (int e = 0; e < 16; ++e) s2 += h[e] * h[e];
        const float rs2 = 1.0f / sqrtf(wave_sum(s2) * (1.f / 1024.f) + EPS);
#pragma unroll
        for (int e = 0; e < 16; ++e) h[e] = h[e] * rs2 * g2[e];
        a.x = pk2(h[0], h[1]); a.y = pk2(h[2], h[3]); a.z = pk2(h[4], h[5]); a.w = pk2(h[6], h[7]); b2.x = pk2(h[8], h[9]); b2.y = pk2(h[10], h[11]); b2.z = pk2(h[12], h[13]); b2.w = pk2(h[14], h[15]);
        *(v4u*)(ur + C_SZ) = a; *(v4u*)(ur + C_SZ + 8) = b2;
    }
}
__device__ __forceinline__ void final_norm_phase(Frame& F) {
    const float* g = inp(F, I_FNG);
    f32x4 gv[4];
#pragma unroll
    for (int j = 0; j < 4; ++j) gv[j] = *(const f32x4*)(g + 4 * F.lane + 256 * j);
    const int gw = F.vcu * NWAVES + F.wave, NGW = F.G * NWAVES;
    for (int i = gw; i < BATCH * SEQ + SROWS; i += NGW) {
        float* xr = F.out + (size_t)i * DM;
        f32x4 v[4]; float s = 0.f;
#pragma unroll
        for (int j = 0; j < 4; ++j) { v[j] = *(const f32x4*)(xr + 4 * F.lane + 256 * j); s += (v[j].x * v[j].x + v[j].y * v[j].y) + (v[j].z * v[j].z + v[j].w * v[j].w); }
        const float rstd = 1.0f / sqrtf(wave_sum(s) * (1.f / DM) + EPS);
#pragma unroll
        for (int j = 0; j < 4; ++j) *(f32x4*)(xr + 4 * F.lane + 256 * j) = v[j] * rstd * gv[j];
    }
}

__global__ void __launch_bounds__(NTHR, 2) fwd_kernel(Args args) {
    extern __shared__ __attribute__((aligned(16))) unsigned char lds[];
    Frame F;
    F.lds = (LAS unsigned char*)lds;
    F.MISC = (volatile LAS unsigned*)(F.lds + MISC_OFF);
    F.tid = threadIdx.x; F.lane = F.tid & 63; F.wave = __builtin_amdgcn_readfirstlane(F.tid >> 6);
    F.G = gridDim.x; { const int bx = blockIdx.x; F.vcu = (F.G % 8 == 0) ? (bx % 8) * (F.G / 8) + bx / 8 : bx; }
    unsigned char* ws = args.ws; F.ws = ws; F.out = args.out;
    F.ctl = (gu32*)(ws + WS_CTL);
    F.U = (bf16*)(ws + WS_U); F.USM = (float*)(ws + WS_USM); F.XN = (bf16*)(ws + WS_XN); F.WIN = (bf16*)(ws + WS_WIN); F.WBR = (bf16*)(ws + WS_WBR);
    F.WOUT = (bf16*)(ws + WS_WOUT); F.WLRU = (bf16*)(ws + WS_WLRU); F.XAUX = (float*)(ws + WS_XAUX);
    for (int u = F.tid; u < (LDS_BYTES - LDSCTL_OFF) / 4; u += NTHR) ((LAS unsigned*)(F.lds + LDSCTL_OFF))[u] = 0u;
    __syncthreads();
    if (F.tid == 0) {
        LAS unsigned long long* t = (LAS unsigned long long*)(F.lds + PTR_OFF);
#pragma unroll
        for (int i = 0; i < 32; ++i) t[i] = (unsigned long long)args.in[i];
    }
    __syncthreads();
    XcdBarrier bar; bar.bar = (unsigned*)(F.ctl + CW_BAR); bar.x = 0; bar.st = nullptr;
    if (N_LAUNCHES == 1) bar = xcd_barrier_post((unsigned*)(F.ctl + CW_BAR), F.MISC + 8);
#define GRID_BAR() do { if (N_LAUNCHES == 1) xcd_barrier(bar); } while (0)
    const int lo = args.ph_lo, hi = args.ph_hi;
#define IN(k) (lo <= (k) && (k) < hi)
#define SEAM(k) do { if (IN(k) && IN((k) + 1)) GRID_BAR(); } while (0)
    if (IN(0)) {
        LAS float* scr = (LAS float*)(F.lds + F.wave * 16384);
        const int gw = F.vcu * NWAVES + F.wave, NGW = F.G * NWAVES;
        for (int it = gw; it < WIN_ITEMS + WSQ_ITEMS + WLRU_ITEMS; it += NGW) {
            if (it < WIN_ITEMS) win_item(F, 0, it, scr);
            else if (it < WIN_ITEMS + WSQ_ITEMS) wsq_item(F, it - WIN_ITEMS, scr);
            else wlru_item(F, it - WIN_ITEMS - WSQ_ITEMS, scr);
        }
        __syncthreads();
        norm_rows(F, 0);
    }
    SEAM(0);
#define LAYER_PHASES(LYR, base) \
    if (IN((base) + 0)) { pg8::Gemm g{(const char*)F.XN, DM, (const char*)F.WIN, DM}; SchedIn S; S.T.init(R / 256, NBIG / 256, F.G, (int)blockIdx.x); \
        EpiU E{F.U}; pg8::gemm_phase<EpiU, SchedIn>(F.lds, g, S, E); } \
    SEAM((base) + 0); \
    if (IN((base) + 1)) { scan_phase(F, LYR); conv_state_out(F, LYR); \
        if ((LYR) == 0) { __syncthreads(); LAS float* scr = (LAS float*)(F.lds + F.wave * 16384); const int gw = F.vcu * NWAVES + F.wave, NGW = F.G * NWAVES; \
            for (int it = gw; it < WIN_ITEMS; it += NGW) win_item(F, 1, it, scr); } } \
    SEAM((base) + 1); \
    if (IN((base) + 2)) { gate_phase(F, LYR); } \
    SEAM((base) + 2); \
    if (IN((base) + 3)) { pg8::Gemm g{(const char*)F.U, NBIG, (const char*)F.WBR, DM}; SchedBr S; S.T.init(R / 256, DM / 256, F.G, (int)blockIdx.x); S.layer = LYR; \
        EpiBr E{F.U, F.XN}; pg8::gemm_phase<EpiBr, SchedBr>(F.lds, g, S, E); } \
    SEAM((base) + 3); \
    if (IN((base) + 4)) { pg8::Gemm g{(const char*)F.XN, DM, (const char*)F.WOUT, DM}; SchedOut S; S.T.init(R / 256, DM / 256, F.G, (int)blockIdx.x); S.layer = LYR; \
        EpiOut E{&F, F.out, F.XAUX, LYR}; pg8::gemm_phase<EpiOut, SchedOut>(F.lds, g, S, E); } \
    SEAM((base) + 4);
    LAYER_PHASES(0, 1)
    if (IN(6)) norm_rows(F, 1);
    SEAM(6);
    LAYER_PHASES(1, 7)
    if (IN(12)) final_norm_phase(F);
#undef IN
#undef SEAM
}

extern "C" void kernel_launch(void* const* d_in, const int* in_sizes, int n_in, void* d_out, int out_size, void* d_ws, size_t ws_size, hipStream_t stream) {
    static int grid = 0;
    if (grid == 0) {
        int dev = 0, cus = 0, per_cu = 0;
        if (hipGetDevice(&dev) != hipSuccess || hipDeviceGetAttribute(&cus, hipDeviceAttributeMultiprocessorCount, dev) != hipSuccess) { fprintf(stderr, "kernel_launch: device query failed\n"); grid = -1; return; }
        if (hipFuncSetAttribute((const void*)fwd_kernel, hipFuncAttributeMaxDynamicSharedMemorySize, LDS_BYTES) != hipSuccess) { fprintf(stderr, "kernel_launch: hipFuncSetAttribute failed\n"); grid = -1; return; }
        if (hipOccupancyMaxActiveBlocksPerMultiprocessor(&per_cu, (const void*)fwd_kernel, NTHR, LDS_BYTES) != hipSuccess || per_cu < 1) { fprintf(stderr, "kernel_launch: occupancy query says %d blocks per CU\n", per_cu); }
        (void)hipGetLastError();
        grid = cus;
        if (ws_size < WS_END) fprintf(stderr, "kernel_launch: workspace too small: %zu < %zu\n", ws_size, (size_t)WS_END);
        if (n_in != 32 || (size_t)out_size != O_END) fprintf(stderr, "kernel_launch: unexpected n_in %d / out_size %d (want 32 / %zu)\n", n_in, out_size, (size_t)O_END);
    }
    if (grid < 0) return;
    (void)in_sizes;
    if (hipMemsetAsync((char*)d_ws + WS_CTL, 0, CTL_ZERO_BYTES, stream) != hipSuccess) { fprintf(stderr, "kernel_launch: memset failed\n"); return; }
    Args a{};
    for (int i = 0; i < 32; ++i) a.in[i] = (const float*)d_in[i];
    a.out = (float*)d_out; a.ws = (unsigned char*)d_ws;
    for (int li = 0; li < N_LAUNCHES; ++li) {
        if (N_LAUNCHES == 1) { a.ph_lo = 0; a.ph_hi = N_PHASES; } else { a.ph_lo = li; a.ph_hi = li + 1; }
        a.li = li;
        hipLaunchKernelGGL(fwd_kernel, dim3(grid), dim3(NTHR), LDS_BYTES, stream, a);
        const hipError_t le = hipPeekAtLastError();
        if (le != hipSuccess) { fprintf(stderr, "kernel_launch: launch %d failed: %s\n", li, hipGetErrorName(le)); break; }
    }
}
```

```cpp
#include <hip/hip_runtime.h>
#include <cstdio>
#include <cstdint>

#ifndef MK_N_LAUNCHES
#define MK_N_LAUNCHES 1
#endif

namespace pg8 {
#define PG8_LAS __attribute__((address_space(3)))
typedef unsigned short bf16_t;
typedef short bf16x8 __attribute__((ext_vector_type(8)));
typedef float f32x4 __attribute__((ext_vector_type(4)));
typedef unsigned u32x4 __attribute__((ext_vector_type(4)));
typedef unsigned u32x2 __attribute__((ext_vector_type(2)));
constexpr int BM = 256, BK = 64, HALF = 128, HTB = HALF * BK * 2, STAGE_BYTES = 8 * HTB, NXCD = 8, WGM = 8;

__host__ __device__ __forceinline__ int lds_byte(int r, int c) { const int st = (r >> 4) * 2 + (c >> 5), rr = r & 15, cc = c & 31, ob = rr * 64 + cc * 2; return st * 1024 + (ob ^ (((ob >> 9) & 1) << 5)); }
__host__ __device__ __forceinline__ void stage_rc(int b, int& R, int& C) { const int st = b / 1024, sb = b % 1024, swz = sb ^ (((sb >> 9) & 1) << 5); R = (st >> 1) * 16 + swz / 64; C = (st & 1) * 32 + (swz % 64) / 2; }
__host__ __device__ __forceinline__ int perm32(int rho) { const int n = rho >> 4, i = rho & 15; return 8 * (i >> 2) + 4 * n + (i & 3); }

struct Unit { int pm, pn, z; };
struct Gemm { const char* A; int lda; const char* Bt; int K; };

__device__ __forceinline__ unsigned cvt_pk_bf16(float lo, float hi) { unsigned r; asm volatile("v_cvt_pk_bf16_f32 %0, %1, %2" : "=v"(r) : "v"(lo), "v"(hi)); return r; }

struct TileOrder {
    int nM, nN, nwg, G, c;
    __device__ void init(int nM_, int nN_, int G_, int c_) { nM = nM_; nN = nN_; nwg = nM * nN; G = G_; c = c_; }
    __device__ bool tile(int i, int& pm, int& pn) const {
        const long L = (long)i * G + c; if (L >= nwg) return false;
        int wgid = (int)L; { const int q = nwg / NXCD, r = nwg % NXCD, xcd = wgid % NXCD, off = wgid / NXCD; wgid = (xcd < r ? xcd * (q + 1) : r * (q + 1) + (xcd - r) * q) + off; }
        const int nig = WGM * nN, gid = wgid / nig, fm = gid * WGM, gsz = (nM - fm) < WGM ? (nM - fm) : WGM;
        pm = fm + ((wgid % nig) % gsz); pn = (wgid % nig) / gsz; return true;
    }
};

template <class Epi, class Sched>
__device__ __forceinline__ void gemm_phase(PG8_LAS unsigned char* lds, const Gemm g, const Sched& S, const Epi& E) {
    const int tid = threadIdx.x, wid = __builtin_amdgcn_readfirstlane(tid >> 6), lane = tid & 63, wr = wid >> 2, wc = wid & 3, fr = lane & 15, fq = lane >> 4;
    const int K = g.K, nt = K / BK, lda = g.lda;
    unsigned voffA[2], voffB[2];
#pragma unroll
    for (int i = 0; i < 2; ++i) { int R, C; stage_rc(tid * 16 + i * 8192, R, C); const int Rb = Epi::PERM ? ((R & ~31) + perm32(R & 31)) : R;
        voffA[i] = (unsigned)(R * lda + C) * 2u; voffB[i] = (unsigned)(Rb * K + C) * 2u; }
    const size_t kstep = (size_t)(BK * 2);
    const size_t hstepA = (size_t)HALF * lda * 2, hstepB = (size_t)HALF * K * 2;
    const unsigned ldsw = (unsigned)wid * 1024u;
    const int aoff = lds_byte(wr * 64 + fr, fq * 8), boff = lds_byte(wc * 32 + fr, fq * 8);
#define PG8_SA(b, h) (((b) * 2 + (h)) * HTB)
#define PG8_SB(b, h) ((4 + (b) * 2 + (h)) * HTB)
#define PG8_STAGE(bufoff, gbase, voff) do { _Pragma("unroll") for (int _i = 0; _i < 2; ++_i) \
        __builtin_amdgcn_global_load_lds((const unsigned*)((const char*)(gbase) + (voff)[_i]), (PG8_LAS unsigned*)(lds + (bufoff) + ldsw + _i * 8192), 16, 0, 0); } while (0)
#define PG8_LDA(dst, b, h) do { _Pragma("unroll") for (int m = 0; m < 4; ++m) _Pragma("unroll") for (int k = 0; k < 2; ++k) dst[m][k] = *(const PG8_LAS bf16x8*)(lds + PG8_SA(b, h) + aoff + m * 2048 + k * 1024); } while (0)
#define PG8_LDB(dst, b, h) do { _Pragma("unroll") for (int n = 0; n < 2; ++n) _Pragma("unroll") for (int k = 0; k < 2; ++k) dst[n][k] = *(const PG8_LAS bf16x8*)(lds + PG8_SB(b, h) + boff + n * 2048 + k * 1024); } while (0)
#define PG8_MMA(ai, bj, At, Bt) do { __builtin_amdgcn_s_setprio(1); _Pragma("unroll") for (int m = 0; m < 4; ++m) _Pragma("unroll") for (int n = 0; n < 2; ++n) _Pragma("unroll") for (int k = 0; k < 2; ++k) \
        acc[ai][bj][m][n] = __builtin_amdgcn_mfma_f32_16x16x32_bf16(Bt[n][k], At[m][k], acc[ai][bj][m][n], 0, 0, 0); __builtin_amdgcn_s_setprio(0); } while (0)
#define PG8_WAIT_V(n) asm volatile("s_waitcnt vmcnt(" #n ")" ::: "memory")
#define PG8_WAIT_L(n) asm volatile("s_waitcnt lgkmcnt(" #n ")" ::: "memory")
#define PG8_BAR __builtin_amdgcn_s_barrier()
#define PG8_SCHED __builtin_amdgcn_sched_barrier(0)
    Unit cur, nxt; int ui = 0;
    int dbgi = 0;
#define PG8_DBG() do { if constexpr (Epi::DBG) { if (tid == 0 && dbgi < 15) ((volatile PG8_LAS unsigned long long*)(lds + 144 * 1024 + 768))[dbgi] = __builtin_amdgcn_s_memrealtime(); ++dbgi; } } while (0)
    PG8_DBG();
    if (!S.next(0, cur)) return;
    f32x4 acc[2][2][4][2];
#pragma unroll
    for (int a = 0; a < 2; ++a)
#pragma unroll
        for (int b = 0; b < 2; ++b)
#pragma unroll
            for (int m = 0; m < 4; ++m)
#pragma unroll
                for (int n = 0; n < 2; ++n) acc[a][b][m][n] = (f32x4){0.f, 0.f, 0.f, 0.f};
    bf16x8 At[4][2], B0[2][2], B1[2][2];
    const char* cA = g.A + S.a_off(cur); const char* cB = g.Bt + S.b_off(cur);
    {
        PG8_STAGE(PG8_SB(0, 0), cB, voffB); PG8_STAGE(PG8_SB(0, 1), cB + hstepB, voffB); PG8_STAGE(PG8_SA(0, 0), cA, voffA); PG8_STAGE(PG8_SA(0, 1), cA + hstepA, voffA);
        if (wr == 1) PG8_BAR;
        PG8_WAIT_V(2); PG8_BAR;
        PG8_STAGE(PG8_SB(1, 0), cB + kstep, voffB); PG8_STAGE(PG8_SA(1, 0), cA + kstep, voffA); PG8_STAGE(PG8_SB(1, 1), cB + hstepB + kstep, voffB);
        PG8_WAIT_V(6); PG8_BAR;
    }
    for (;;) {
        const bool has_next = S.next(ui + 1, nxt);
        const char* nA = has_next ? g.A + S.a_off(nxt) : cA; const char* nB = has_next ? g.Bt + S.b_off(nxt) : cB;
        for (int t = 0; t < nt; t += 2) {
            const bool last = (t == nt - 2);
            const char* a1 = cA + (size_t)(t + 1) * kstep;
            const char* a2 = last ? nA : cA + (size_t)(t + 2) * kstep; const char* b2 = last ? nB : cB + (size_t)(t + 2) * kstep;
            const char* a3 = a2 + kstep; const char* b3 = b2 + kstep;
            PG8_LDB(B0, 0, 0); PG8_LDB(B1, 0, 1); PG8_SCHED; PG8_LDA(At, 0, 0); PG8_STAGE(PG8_SA(1, 1), a1 + hstepA, voffA);
            PG8_WAIT_V(8); PG8_WAIT_L(0); PG8_BAR; PG8_MMA(0, 0, At, B0); PG8_MMA(0, 1, At, B1); PG8_BAR; PG8_SCHED;
            PG8_LDA(At, 0, 1); PG8_STAGE(PG8_SB(0, 0), b2, voffB); PG8_STAGE(PG8_SB(0, 1), b2 + hstepB, voffB); PG8_STAGE(PG8_SA(0, 0), a2, voffA);
            PG8_WAIT_V(8); PG8_WAIT_L(0); PG8_BAR; PG8_MMA(1, 0, At, B0); PG8_MMA(1, 1, At, B1); PG8_BAR; PG8_SCHED;
            PG8_LDB(B0, 1, 0); PG8_LDB(B1, 1, 1); PG8_SCHED; PG8_LDA(At, 1, 0); PG8_STAGE(PG8_SA(0, 1), a2 + hstepA, voffA);
            PG8_WAIT_V(8); PG8_WAIT_L(0); PG8_BAR; PG8_MMA(0, 0, At, B0); PG8_MMA(0, 1, At, B1); PG8_BAR; PG8_SCHED;
            PG8_LDA(At, 1, 1); PG8_STAGE(PG8_SB(1, 0), b3, voffB); PG8_STAGE(PG8_SB(1, 1), b3 + hstepB, voffB); PG8_STAGE(PG8_SA(1, 0), a3, voffA);
            PG8_WAIT_V(8); PG8_WAIT_L(0); PG8_BAR; PG8_MMA(1, 0, At, B0); PG8_MMA(1, 1, At, B1); PG8_BAR; PG8_SCHED;
        }
        if (wr == 0) PG8_BAR;
        PG8_DBG();
        const bool rst = E(acc, cur, wr, wc, fr, fq);
        PG8_DBG();
        if (!has_next) break;
        if (rst) {
#pragma unroll
        for (int a = 0; a < 2; ++a)
#pragma unroll
            for (int b = 0; b < 2; ++b)
#pragma unroll
                for (int m = 0; m < 4; ++m)
#pragma unroll
                    for (int n = 0; n < 2; ++n) acc[a][b][m][n] = (f32x4){0.f, 0.f, 0.f, 0.f};
        }
        cur = nxt; cA = nA; cB = nB; ++ui;
        if (wr == 1) PG8_BAR;
    }
    PG8_WAIT_V(0);
    PG8_BAR;
#undef PG8_SA
#undef PG8_SB
#undef PG8_STAGE
#undef PG8_LDA
#undef PG8_LDB
#undef PG8_MMA
#undef PG8_WAIT_V
#undef PG8_WAIT_L
#undef PG8_BAR
#undef PG8_SCHED
}
}

constexpr int NWAVES = 8, NTHR = 512;
constexpr int N_LAUNCHES = MK_N_LAUNCHES;
constexpr int N_PHASES = 13;
constexpr int DM = 1024, BATCH = 8, SEQ = 2048, DECB = 128, DECS = 8, NMETA = 16;
constexpr int PT = SEQ + NMETA;
constexpr int ROW0 = 48;
constexpr int PROWS = BATCH * PT;
constexpr int SROW0 = ROW0 + PROWS;
constexpr int SROWS = DECB * DECS;
constexpr int RTOK = SROW0 + SROWS;
constexpr int R = 17664;
constexpr int NCH = 33;
constexpr int NIN = 12312, NBIG = 12288;
constexpr int LDU = NBIG + 64;
constexpr int C_Q = 0, C_K = 512, C_V = 1024, C_O = 2048, C_Z = 3072, C_LX = 4096, C_LZ = 5120, C_SZ = 6144, C_XBC = 7168, C_G = 9216;
constexpr int C_TMP = 2048;
constexpr int USMW = 32;
constexpr float EPS = 1e-6f;

constexpr size_t MiB = 1u << 20;
constexpr size_t WS_CTL = 0, CTL_ZERO_BYTES = 1 * MiB;
constexpr size_t WS_U = 1 * MiB;
constexpr size_t WS_USM = WS_U + (size_t)R * LDU * 2;
constexpr size_t WS_XN = WS_USM + (size_t)R * USMW * 4;
constexpr size_t WS_WIN = WS_XN + (size_t)R * DM * 2;
constexpr size_t WS_WBR = WS_WIN + (size_t)NBIG * DM * 2;
constexpr size_t WS_WOUT = WS_WBR + (size_t)6 * DM * DM * 2;
constexpr size_t WS_WLRU = WS_WOUT + (size_t)2 * DM * DM * 2;
constexpr size_t WS_XAUX = WS_WLRU + (size_t)2 * 2 * 16 * 64 * 64 * 2;
constexpr size_t WS_END = WS_XAUX + (size_t)256 * DM * 4;
static_assert(WS_END <= 512 * MiB, "d_ws map must fit 512 MiB");
static_assert(WS_USM % 256 == 0 && WS_XN % 256 == 0 && WS_WIN % 256 == 0 && WS_WBR % 256 == 0 && WS_WLRU % 256 == 0 && WS_XAUX % 256 == 0, "alignment");
constexpr int CW_TMO = 0, CW_CODE = 1, CW_BAR = 4096;
constexpr size_t O_YP = 0, O_YS = O_YP + (size_t)BATCH * SEQ * DM, O_PC = O_YS + (size_t)SROWS * DM, O_PN = O_PC + (size_t)2 * 8 * 4 * 128 * 256,
    O_PM = O_PN + 2 * 8 * 4 * 128, O_PHL = O_PM + 2 * 8 * 4, O_PCL = O_PHL + 2 * 8 * 1024, O_PHS = O_PCL + 2 * 8 * 3 * 1024, O_PCS = O_PHS + (size_t)2 * 8 * 16 * 64 * 128,
    O_SC = O_PCS + 2 * 8 * 3 * 2048, O_SN = O_SC + (size_t)2 * 128 * 4 * 128 * 256, O_SM = O_SN + 2 * 128 * 4 * 128, O_SHL = O_SM + 2 * 128 * 4, O_SCL = O_SHL + 2 * 128 * 1024,
    O_SHS = O_SCL + 2 * 128 * 3 * 1024, O_SCS = O_SHS + (size_t)2 * 128 * 16 * 64 * 128, O_END = O_SCS + 2 * 128 * 3 * 2048;

constexpr int RING_BYTES = 131072;
constexpr int LDSCTL_OFF = 144 * 1024, MISC_OFF = LDSCTL_OFF + 320;
constexpr int LDS_BYTES = 147456 + 1024;
static_assert(MISC_OFF + 128 <= LDS_BYTES, "LDS map");

#define GAS __attribute__((address_space(1)))
#define LAS __attribute__((address_space(3)))
typedef unsigned short bf16;
typedef unsigned v4u __attribute__((ext_vector_type(4)));
typedef unsigned v2u __attribute__((ext_vector_type(2)));
typedef float f32x4 __attribute__((ext_vector_type(4)));
typedef float f32x2 __attribute__((ext_vector_type(2)));
typedef short bf16x8 __attribute__((ext_vector_type(8)));
typedef GAS unsigned gu32;
#define RLX_AGENT __ATOMIC_RELAXED, __HIP_MEMORY_SCOPE_AGENT
#define LDS_WAIT() asm volatile("s_waitcnt lgkmcnt(0)" ::: "memory")
#define VM_WAIT() asm volatile("s_waitcnt vmcnt(0)" ::: "memory")
__device__ __forceinline__ unsigned f2bf(float f) { unsigned u = __builtin_bit_cast(unsigned, f); return (u + 0x7fffu + ((u >> 16) & 1u)) >> 16; }
__device__ __forceinline__ unsigned pk2(float lo, float hi) { return f2bf(lo) | (f2bf(hi) << 16); }
__device__ __forceinline__ float bf2f(unsigned short b) { return __builtin_bit_cast(float, (unsigned)b << 16); }
__device__ __forceinline__ float bflo(unsigned w) { return __builtin_bit_cast(float, w << 16); }
__device__ __forceinline__ float bfhi(unsigned w) { return __builtin_bit_cast(float, w & 0xffff0000u); }
__device__ __forceinline__ float sigmoidf_(float x) { return 1.f / (1.f + __expf(-x)); }
__device__ __forceinline__ float siluf_(float x) { return x / (1.f + __expf(-x)); }
__device__ __forceinline__ float softplusf_(float x) { return fmaxf(x, 0.f) + log1pf(__expf(-fabsf(x))); }
__device__ __forceinline__ float logsigmoidf_(float x) { return fminf(x, 0.f) - log1pf(__expf(-fabsf(x))); }
__device__ __forceinline__ float wave_sum(float v) {
#pragma unroll
    for (int o = 1; o < 64; o <<= 1) v += __shfl_xor(v, o);
    return v;
}

#define XB_TMO      128
#define XB_XCNT(j)  (256  + 64 * (j))
#define XB_XSUB(j)  (1280 + 64 * (j))
#define XB_XGEN(j)  (2304 + 64 * (j))
#define XB_TOP      3328
#define XB_TOPGEN   3392
#define XCD_BAR_WORDS 3456
#define XB_SPIN_CAP (1u << 22)
__device__ __forceinline__ unsigned xb_ld(unsigned* p)              { return __hip_atomic_load(p, __ATOMIC_RELAXED, __HIP_MEMORY_SCOPE_AGENT); }
__device__ __forceinline__ unsigned xb_add(unsigned* p, unsigned v) { return __hip_atomic_fetch_add(p, v, __ATOMIC_RELAXED, __HIP_MEMORY_SCOPE_AGENT); }
__device__ __forceinline__ unsigned xb_xcc_id() { return (unsigned)__builtin_amdgcn_s_getreg((3 << 11) | 20) & 0xFu; }
#define XB_SPIN(cond, bar) do { unsigned _sp = 0; while (cond) { __builtin_amdgcn_s_sleep(1); \
    if ((++_sp & 255u) == 0u) { if (xb_ld(&(bar)[XB_TMO])) break; if (_sp > XB_SPIN_CAP) { atomicAdd(&(bar)[XB_TMO], 1u); break; } } } } while (0)
struct XcdBarrier { unsigned* bar; unsigned x; volatile LAS unsigned* st; };
__device__ __forceinline__ XcdBarrier xcd_barrier_post(unsigned* bar, volatile LAS unsigned* st) {
    XcdBarrier b; b.bar = bar; b.x = xb_xcc_id(); b.st = st;
    if (threadIdx.x == 0) (void)xb_add(&bar[XB_XCNT(b.x)], 1u);
    return b;
}
__device__ __forceinline__ void xcd_barrier_complete(unsigned* bar, unsigned x, unsigned& nloc, unsigned& nx) {
    const unsigned G = gridDim.x * gridDim.y * gridDim.z;
    unsigned sum, cnt, mine, sp = 0u;
    for (;;) {
        sum = 0u; cnt = 0u; mine = 0u;
#pragma unroll
        for (unsigned j = 0; j < 16; ++j) { const unsigned c = xb_ld(&bar[XB_XCNT(j)]); sum += c; cnt += (c > 0u) ? 1u : 0u; mine = (j == x) ? c : mine; }
        if (sum == G) break;
        __builtin_amdgcn_s_sleep(1);
        if ((++sp & 255u) == 0u) { if (xb_ld(&bar[XB_TMO])) break; if (sp > XB_SPIN_CAP) { atomicAdd(&bar[XB_TMO], 1u); break; } }
    }
    nloc = mine > 0u ? mine : 1u; nx = cnt > 0u ? cnt : 1u;
}
__device__ __forceinline__ void xcd_barrier(const XcdBarrier& b) {
    asm volatile("s_waitcnt vmcnt(0)" ::: "memory");
    __syncthreads();
    if (threadIdx.x == 0) {
        unsigned* bar = b.bar;
        __builtin_amdgcn_s_waitcnt(0);
        unsigned nloc = b.st[0], nx = b.st[1];
        if (nloc == 0u) { xcd_barrier_complete(bar, b.x, nloc, nx); b.st[0] = nloc; b.st[1] = nx; }
        const unsigned old = xb_add(&bar[XB_XSUB(b.x)], 1u);
        const unsigned gen = old / nloc;
        if (old + 1u == (gen + 1u) * nloc) {
            __builtin_amdgcn_fence(__ATOMIC_RELEASE, "agent");
            asm volatile("s_waitcnt vmcnt(0)" ::: "memory");
            const unsigned og = xb_add(&bar[XB_TOP], 1u);
            const unsigned tg = og / nx;
            if (og + 1u == (tg + 1u) * nx) xb_add(&bar[XB_TOPGEN], 1u);
            else XB_SPIN(xb_ld(&bar[XB_TOPGEN]) == tg, bar);
            __builtin_amdgcn_fence(__ATOMIC_ACQUIRE, "agent");
            xb_add(&bar[XB_XGEN(b.x)], 1u);
            asm volatile("s_waitcnt vmcnt(0)" ::: "memory");
        } else {
            XB_SPIN(xb_ld(&bar[XB_XGEN(b.x)]) == gen, bar);
            __builtin_amdgcn_fence(__ATOMIC_ACQUIRE, "agent");
            asm volatile("s_waitcnt vmcnt(0)" ::: "memory");
        }
    }
    __syncthreads();
}

struct Args { const float* in[32]; float* out; unsigned char* ws; int ph_lo, ph_hi, li, pad; };
struct Frame {
    LAS unsigned char* lds;
    volatile LAS unsigned* MISC;
    gu32* ctl;
    int tid, lane, wave, vcu, G;
    float* out; unsigned char* ws;
    bf16 *U, *XN, *WIN, *WBR, *WOUT, *WLRU; float *USM, *XAUX;
};
enum { I_XP = 0, I_XS, I_SC, I_SN, I_SM, I_SHL, I_SCL, I_SHS, I_SCS, I_META, I_WIN, I_NORMG, I_FBIAS, I_MLNG, I_LCW, I_LCB, I_LWA, I_LBA, I_LWX, I_LBX, I_LLAM,
       I_SCW, I_SCB, I_SDTB, I_SALOG, I_SD, I_SNG, I_WBML, I_WBLRU, I_WBSSD, I_WOUT, I_FNG };

constexpr int PTR_OFF = LDSCTL_OFF + 512;
__device__ __forceinline__ const float* inp(const Frame& F, int i) {
    const volatile LAS unsigned* t = (const volatile LAS unsigned*)(F.lds + PTR_OFF) + 2 * i;
    const unsigned lo = __builtin_amdgcn_readfirstlane(t[0]), hi = __builtin_amdgcn_readfirstlane(t[1]);
    return (const float*)(((unsigned long long)hi << 32) | lo);
}
__device__ __forceinline__ const float* x0_row(const Frame& a, int row) {
    if (row < ROW0 || row >= RTOK) return nullptr;
    if (row >= SROW0) return inp(a, I_XS) + (size_t)(row - SROW0) * DM;
    const int p = row - ROW0, b = p / PT, t = p - b * PT;
    if (t < NMETA) return inp(a, I_META) + (size_t)t * DM;
    return inp(a, I_XP) + ((size_t)b * SEQ + (t - NMETA)) * DM;
}
__device__ __forceinline__ float* x1_row(float* out, float* xaux, int row) {
    if (row < ROW0) return xaux + (size_t)row * DM;
    if (row >= RTOK) return xaux + (size_t)(176 + row - RTOK) * DM;
    if (row >= SROW0) return out + O_YS + (size_t)(row - SROW0) * DM;
    const int p = row - ROW0, b = p / PT, t = p - b * PT;
    if (t < NMETA) return xaux + (size_t)(48 + b * NMETA + t) * DM;
    return out + O_YP + ((size_t)b * SEQ + (t - NMETA)) * DM;
}

__device__ __forceinline__ void transpose_item(const float* W, int ldw, int K, bf16* WT, int k0, int csrc0, int orow0, float scale, LAS float* scr, int lane) {
#pragma unroll 8
    for (int i = 0; i < 32; ++i) { const int kk = 2 * i + (lane >> 5); scr[kk * 33 + (lane & 31)] = W[(size_t)(k0 + kk) * ldw + csrc0 + (lane & 31)]; }
    LDS_WAIT(); asm volatile("" ::: "memory");
    const int c = lane & 7;
#pragma unroll
    for (int j = 0; j < 4; ++j) { const int n = (lane >> 3) + 8 * j; const LAS float* s = scr + (8 * c) * 33 + n;
        v4u o; o.x = pk2(s[0 * 33] * scale, s[1 * 33] * scale); o.y = pk2(s[2 * 33] * scale, s[3 * 33] * scale); o.z = pk2(s[4 * 33] * scale, s[5 * 33] * scale); o.w = pk2(s[6 * 33] * scale, s[7 * 33] * scale);
        *(GAS v4u*)(WT + (size_t)(orow0 + n) * K + k0 + 8 * c) = o; }
    LDS_WAIT(); asm volatile("" ::: "memory");
}
__device__ __forceinline__ void win_item(Frame& F, int layer, int it, LAS float* scr) {
    const int kb = it / 384, nb = it % 384, n0 = nb * 32;
    const int csrc = n0 + (n0 >= 2048 ? 8 : 0) + (n0 >= 9216 ? 16 : 0);
    const float scale = (n0 >= C_K && n0 < C_V) ? 0.08838834764831845f : 1.0f;
    transpose_item(inp(F, I_WIN) + (size_t)layer * DM * NIN, NIN, DM, F.WIN, kb * 64, csrc, n0, scale, scr, F.lane);
}
constexpr int WIN_ITEMS = 16 * 384;
constexpr int WSQ_ITEMS = 2 * 4 * 512, WLRU_ITEMS = 2 * 2 * 16 * 2;
__device__ __forceinline__ void wsq_item(Frame& F, int it, LAS float* scr) {
    const int layer = it / 2048, r = it % 2048, m = r / 512, q = r % 512, kb = q / 32, nb = q % 32;
    const float* W = inp(F, m == 0 ? I_WBML : m == 1 ? I_WBLRU : m == 2 ? I_WBSSD : I_WOUT) + (size_t)layer * DM * DM;
    bf16* WT = (m < 3) ? F.WBR + ((size_t)layer * 3 + m) * DM * DM : F.WOUT + (size_t)layer * DM * DM;
    transpose_item(W, DM, DM, WT, kb * 64, nb * 32, nb * 32, 1.0f, scr, F.lane);
}
__device__ __forceinline__ void wlru_item(Frame& F, int it, LAS float* scr) {
    const int nb = it & 1, blk = (it >> 1) & 15, ax = (it >> 5) & 1, layer = it >> 6;
    const float* W = inp(F, ax ? I_LWX : I_LWA) + ((size_t)layer * 16 + blk) * 64 * 64;
    bf16* WT = F.WLRU + (((size_t)layer * 2 + ax) * 16 + blk) * 64 * 64;
    transpose_item(W, 64, 64, WT, 0, nb * 32, nb * 32, 1.0f, scr, F.lane);
}
constexpr int WSM_LD = 1028;
__device__ __forceinline__ void norm_rows(Frame& F, int layer) {
    LAS float* Wsm = (LAS float*)F.lds;
    const float* W = inp(F, I_WIN) + (size_t)layer * DM * NIN;
    for (int idx = F.tid; idx < 24 * DM; idx += NTHR) { const int k = idx / 24, c = idx - k * 24; const int col = (c < 8) ? 2048 + c : 9224 + (c - 8);
        Wsm[c * WSM_LD + k] = W[(size_t)k * NIN + col]; }
    __syncthreads();
    const float* g = inp(F, I_NORMG) + layer * DM;
    f32x4 gv[4];
#pragma unroll
    for (int j = 0; j < 4; ++j) gv[j] = *(const f32x4*)(g + 4 * F.lane + 256 * j);
    const int gw = F.vcu * NWAVES + F.wave, NGW = F.G * NWAVES;
    const bool b5 = (F.lane & 32) != 0, b4 = (F.lane & 16) != 0, b3 = (F.lane & 8) != 0;
    f32x4 vn[4]; bool realn = false;
    { const int row = gw; const float* xr = (row < R) ? ((layer == 0) ? x0_row(F, row) : (const float*)x1_row(F.out, F.XAUX, row)) : nullptr;
      realn = (xr != nullptr) && row >= ROW0 && row < RTOK;
      if (realn) {
#pragma unroll
          for (int j = 0; j < 4; ++j) vn[j] = *(const f32x4*)(xr + 4 * F.lane + 256 * j); } }
    for (int row = gw; row < R; row += NGW) {
        f32x4 v[4]; const bool real = realn;
#pragma unroll
        for (int j = 0; j < 4; ++j) v[j] = vn[j];
        { const int rn = row + NGW; const float* xr = (rn < R) ? ((layer == 0) ? x0_row(F, rn) : (const float*)x1_row(F.out, F.XAUX, rn)) : nullptr;
          realn = (xr != nullptr) && rn >= ROW0 && rn < RTOK;
          if (realn) {
#pragma unroll
              for (int j = 0; j < 4; ++j) vn[j] = *(const f32x4*)(xr + 4 * F.lane + 256 * j); } }
        GAS unsigned long long* o8 = (GAS unsigned long long*)(F.XN + (size_t)row * DM) + F.lane;
        float* us = F.USM + (size_t)row * USMW;
        if (!real) {
#pragma unroll
            for (int j = 0; j < 4; ++j) o8[64 * j] = 0ull;
            if (F.lane < USMW) us[F.lane] = 0.f;
            continue;
        }
        float s = 0.f;
#pragma unroll
        for (int j = 0; j < 4; ++j) s += (v[j].x * v[j].x + v[j].y * v[j].y) + (v[j].z * v[j].z + v[j].w * v[j].w);
        const float rstd = 1.0f / sqrtf(wave_sum(s) * (1.f / DM) + EPS);
#pragma unroll
        for (int j = 0; j < 4; ++j) { v[j] = v[j] * rstd * gv[j];
            o8[64 * j] = (unsigned long long)pk2(v[j].x, v[j].y) | ((unsigned long long)pk2(v[j].z, v[j].w) << 32); }
#pragma unroll
        for (int g8 = 0; g8 < 3; ++g8) {
            float d[8];
#pragma unroll
            for (int c = 0; c < 8; ++c) { float a = 0.f;
#pragma unroll
                for (int j = 0; j < 4; ++j) { const f32x4 w = *(const LAS f32x4*)(Wsm + (g8 * 8 + c) * WSM_LD + 4 * F.lane + 256 * j); a += (v[j].x * w.x + v[j].y * w.y) + (v[j].z * w.z + v[j].w * w.w); }
                d[c] = a; }
            float w4[4], x2[2];
#pragma unroll
            for (int i = 0; i < 4; ++i) { const float send = b5 ? d[i] : d[4 + i], keep = b5 ? d[4 + i] : d[i]; w4[i] = keep + __shfl_xor(send, 32); }
#pragma unroll
            for (int i = 0; i < 2; ++i) { const float send = b4 ? w4[i] : w4[2 + i], keep = b4 ? w4[2 + i] : w4[i]; x2[i] = keep + __shfl_xor(send, 16); }
            float y; { const float send = b3 ? x2[0] : x2[1], keep = b3 ? x2[1] : x2[0]; y = keep + __shfl_xor(send, 8); }
            y += __shfl_xor(y, 4); y += __shfl_xor(y, 2); y += __shfl_xor(y, 1);
            if ((F.lane & 7) == 0) us[g8 * 8 + (F.lane >> 3)] = y;
        }
        if (F.lane < 8) us[24 + F.lane] = 0.f;
    }
}
__device__ __forceinline__ void unpack16(const v4u a, const v4u b, float (&o)[16]) {
    o[0] = bflo(a.x); o[1] = bfhi(a.x); o[2] = bflo(a.y); o[3] = bfhi(a.y); o[4] = bflo(a.z); o[5] = bfhi(a.z); o[6] = bflo(a.w); o[7] = bfhi(a.w);
    o[8] = bflo(b.x); o[9] = bfhi(b.x); o[10] = bflo(b.y); o[11] = bfhi(b.y); o[12] = bflo(b.z); o[13] = bfhi(b.z); o[14] = bflo(b.w); o[15] = bfhi(b.w);
}

struct SchedIn {
    pg8::TileOrder T;
    __device__ __forceinline__ bool next(int i, pg8::Unit& u) const { u.z = 0; return T.tile(i, u.pm, u.pn); }
    __device__ __forceinline__ size_t a_off(const pg8::Unit& u) const { return (size_t)u.pm * 256 * DM * 2; }
    __device__ __forceinline__ size_t b_off(const pg8::Unit& u) const { return (size_t)u.pn * 256 * DM * 2; }
};
struct EpiU {
    static constexpr bool PERM = true, DBG = false;
    bf16* U;
    __device__ __forceinline__ bool operator()(f32x4 (&acc)[2][2][4][2], const pg8::Unit& u, int wr, int wc, int fr, int fq) const {
        const int row0 = u.pm * 256 + wr * 64 + fr;
        if (u.pn * 256 >= C_G) {
            const int col0 = u.pn * 256 + (wc * 4 + fq) * 16;
#pragma unroll
            for (int ai = 0; ai < 2; ++ai)
#pragma unroll
                for (int m = 0; m < 4; ++m) { bf16* rowp = U + (size_t)(row0 + ai * 128 + m * 16) * LDU + col0;
#pragma unroll
                    for (int bj = 0; bj < 2; ++bj) { const f32x4 v0 = acc[ai][bj][m][0], v1 = acc[ai][bj][m][1];
                        v4u w; w.x = pg8::cvt_pk_bf16(sigmoidf_(v0[0]), sigmoidf_(v0[1])); w.y = pg8::cvt_pk_bf16(sigmoidf_(v0[2]), sigmoidf_(v0[3]));
                        w.z = pg8::cvt_pk_bf16(sigmoidf_(v1[0]), sigmoidf_(v1[1])); w.w = pg8::cvt_pk_bf16(sigmoidf_(v1[2]), sigmoidf_(v1[3]));
                        *(v4u*)(rowp + bj * 8) = w; } }
            return true;
        }
        const int col0 = u.pn * 256 + wc * 32 + 8 * fq;
#pragma unroll
        for (int ai = 0; ai < 2; ++ai)
#pragma unroll
            for (int m = 0; m < 4; ++m) { bf16* rowp = U + (size_t)(row0 + ai * 128 + m * 16) * LDU + col0;
#pragma unroll
                for (int bj = 0; bj < 2; ++bj) { const f32x4 v0 = acc[ai][bj][m][0], v1 = acc[ai][bj][m][1];
                    v4u w; w.x = pg8::cvt_pk_bf16(v0[0], v0[1]); w.y = pg8::cvt_pk_bf16(v0[2], v0[3]); w.z = pg8::cvt_pk_bf16(v1[0], v1[1]); w.w = pg8::cvt_pk_bf16(v1[2], v1[3]);
                    *(v4u*)(rowp + bj * 128) = w; } }
        return true;
    }
};
struct SchedBr {
    pg8::TileOrder T; int layer;
    __device__ __forceinline__ bool next(int i, pg8::Unit& u) const { u.z = i % 3; return T.tile(i / 3, u.pm, u.pn); }
    __device__ __forceinline__ size_t a_off(const pg8::Unit& u) const { const int col = (u.z == 0) ? C_V : (u.z == 1) ? C_LZ : C_SZ; return ((size_t)u.pm * 256 * LDU + col) * 2; }
    __device__ __forceinline__ size_t b_off(const pg8::Unit& u) const { return ((size_t)(layer * 3 + u.z) * DM * DM + (size_t)u.pn * 256 * DM) * 2; }
};
struct EpiBr {
    static constexpr bool PERM = true;
#if defined(DBG_TIMING) && DBG_TIMING == 3
    static constexpr bool DBG = true;
#else
    static constexpr bool DBG = false;
#endif
    bf16* U; bf16* MG;
    __device__ __forceinline__ bool operator()(f32x4 (&acc)[2][2][4][2], const pg8::Unit& u, int wr, int wc, int fr, int fq) const {
        const int row0 = u.pm * 256 + wr * 64 + fr, gcol = C_G + u.pn * 256 + (wc * 4 + fq) * 16, col0 = u.pn * 256 + wc * 32 + 8 * fq;
#pragma unroll
        for (int ai = 0; ai < 2; ++ai)
#pragma unroll
            for (int m = 0; m < 4; ++m) { const int row = row0 + ai * 128 + m * 16; const bf16* ur = U + (size_t)row * LDU + gcol;
                const v4u ga0 = *(const v4u*)(ur + u.z * DM), ga1 = *(const v4u*)(ur + u.z * DM + 8);
                float a[16]; unpack16(ga0, ga1, a);
                if (u.z < 2) { const v4u gb0 = *(const v4u*)(ur + (u.z + 1) * DM), gb1 = *(const v4u*)(ur + (u.z + 1) * DM + 8);
                    float b[16]; unpack16(gb0, gb1, b);
#pragma unroll
                    for (int bj = 0; bj < 2; ++bj)
#pragma unroll
                        for (int n = 0; n < 2; ++n)
#pragma unroll
                            for (int e = 0; e < 4; ++e) acc[ai][bj][m][n][e] *= a[bj * 8 + n * 4 + e] * __builtin_amdgcn_rcpf(fmaxf(b[bj * 8 + n * 4 + e], 1e-30f));
                } else {
#pragma unroll
                    for (int bj = 0; bj < 2; ++bj) { f32x4 v0 = acc[ai][bj][m][0], v1 = acc[ai][bj][m][1];
#pragma unroll
                        for (int e = 0; e < 4; ++e) { v0[e] *= a[bj * 8 + e]; v1[e] *= a[bj * 8 + 4 + e]; }
                        v4u w; w.x = pg8::cvt_pk_bf16(v0[0], v0[1]); w.y = pg8::cvt_pk_bf16(v0[2], v0[3]); w.z = pg8::cvt_pk_bf16(v1[0], v1[1]); w.w = pg8::cvt_pk_bf16(v1[2], v1[3]);
                        *(v4u*)(MG + (size_t)row * DM + col0 + bj * 128) = w; }
                } }
        return u.z == 2;
    }
};
struct SchedOut {
    pg8::TileOrder T; int layer;
    __device__ __forceinline__ bool next(int i, pg8::Unit& u) const { u.z = 0; return T.tile(i, u.pm, u.pn); }
    __device__ __forceinline__ size_t a_off(const pg8::Unit& u) const { return (size_t)u.pm * 256 * DM * 2; }
    __device__ __forceinline__ size_t b_off(const pg8::Unit& u) const { return ((size_t)layer * DM * DM + (size_t)u.pn * 256 * DM) * 2; }
};
struct EpiOut {
    static constexpr bool PERM = false, DBG = false;
    const Frame* a; float* out; float* xaux; int layer;
    __device__ __forceinline__ bool operator()(f32x4 (&acc)[2][2][4][2], const pg8::Unit& u, int wr, int wc, int fr, int fq) const {
        const int row0 = u.pm * 256 + wr * 64 + fr, col0 = u.pn * 256 + wc * 32 + 4 * fq;
#pragma unroll
        for (int ai = 0; ai < 2; ++ai)
#pragma unroll
            for (int m = 0; m < 4; ++m) { const int row = row0 + ai * 128 + m * 16;
                float* dst = x1_row(out, xaux, row); const float* src = (layer == 0) ? x0_row(*a, row) : (const float*)dst;
#pragma unroll
                for (int bj = 0; bj < 2; ++bj)
#pragma unroll
                    for (int n = 0; n < 2; ++n) { const int col = col0 + bj * 128 + n * 16;
                        f32x4 v = acc[ai][bj][m][n]; if (src) v = v + *(const f32x4*)(src + col);
                        *(f32x4*)(dst + col) = v; } }
        return true;
    }
};

__device__ __forceinline__ void conv_state_out(Frame& F, int layer) {
    const int gt = F.vcu * NTHR + F.tid, NG = F.G * NTHR;
    for (int i = gt; i < BATCH * 3 * 1024; i += NG) { const int ch = i & 1023, j = (i >> 10) % 3, b = i / 3072; const int row = ROW0 + b * PT + (PT - 3) + j;
        F.out[O_PCL + ((size_t)(layer * BATCH + b) * 3 + j) * 1024 + ch] = bf2f(F.U[(size_t)row * LDU + C_LX + ch]); }
    for (int i = gt; i < BATCH * 3 * 2048; i += NG) { const int ch = i & 2047, j = (i >> 11) % 3, b = i / 6144; const int row = ROW0 + b * PT + (PT - 3) + j;
        F.out[O_PCS + ((size_t)(layer * BATCH + b) * 3 + j) * 2048 + ch] = bf2f(F.U[(size_t)row * LDU + C_XBC + ch]); }
    for (int i = gt; i < DECB * 3 * 1024; i += NG) { const int ch = i & 1023, j = (i >> 10) % 3, b = i / 3072; const int row = SROW0 + b * DECS + (DECS - 3) + j;
        F.out[O_SCL + ((size_t)(layer * DECB + b) * 3 + j) * 1024 + ch] = bf2f(F.U[(size_t)row * LDU + C_LX + ch]); }
    for (int i = gt; i < DECB * 3 * 2048; i += NG) { const int ch = i & 2047, j = (i >> 11) % 3, b = i / 6144; const int row = SROW0 + b * DECS + (DECS - 3) + j;
        F.out[O_SCS + ((size_t)(layer * DECB + b) * 3 + j) * 2048 + ch] = bf2f(F.U[(size_t)row * LDU + C_XBC + ch]); }
}

#define MFMA16(a, b, c) __builtin_amdgcn_mfma_f32_16x16x32_bf16(a, b, c, 0, 0, 0)
__device__ __forceinline__ bf16x8 ldfrag(const LAS unsigned char* base, int ld, int row, int k) { return *(const LAS bf16x8*)(base + (row * ld + k) * 2); }
__device__ __forceinline__ float scan_add(float x, int lane) {
#pragma unroll
    for (int o = 1; o < 64; o <<= 1) { const float t = __shfl_up(x, o); if (lane >= o) x += t; }
    return x;
}
__device__ __forceinline__ float scan_max(float x, int lane) {
#pragma unroll
    for (int o = 1; o < 64; o <<= 1) { const float t = __shfl_up(x, o); if (lane >= o) x = fmaxf(x, t); }
    return x;
}
constexpr int L_QS = 0, L_KS = 17408, L_KT = 34816, L_VT = 53248, L_PS = 57856, L_CT = 67072, L_FA = 84480, L_VX = 88576, L_CW = 96768;
constexpr int LDQ = 136, LDT = 72;
constexpr int FA_COLV = 0, FA_ROWV = 64, FA_INTER = 128, FA_KS = 192, FA_CLAMP = 256, FA_DENS = 320, FA_QN = 384, FA_NVEC = 448, FA_SC = 576;

template <bool IS_ML>
__device__ __forceinline__ void chunk_scan_item(Frame& F, int layer, int item) {
    const int tid = F.tid, lane = F.lane, w = F.wave, fr = lane & 15, fq = lane >> 4;
    LAS unsigned char* lds = F.lds;
    LAS float* fa = (LAS float*)(lds + L_FA);
    LAS float* vx = (LAS float*)(lds + L_VX);
    LAS float* cw = (LAS float*)(lds + L_CW);
    int b, hd, sl;
    if (IS_ML) { b = item >> 5; hd = (item >> 3) & 3; sl = item & 7; } else { b = item >> 5; hd = (item >> 1) & 15; sl = item & 1; }
    const int grp = hd >> 2;
    const int seq0 = ROW0 + b * PT;
    const int qcol = IS_ML ? C_Q + hd * 128 : C_XBC + 1536 + grp * 128;
    const int kcol = IS_ML ? C_K + hd * 128 : C_XBC + 1024 + grp * 128;
    const int vcol = IS_ML ? C_V + hd * 256 + sl * 32 : C_XBC + hd * 64 + sl * 32;
    const int zcol = C_SZ + hd * 64 + sl * 32;
    float fbias = 0.f, dtb = 0.f, aneg = 0.f, dskip = 0.f;
    if (IS_ML) fbias = inp(F, I_FBIAS)[layer * 4 + hd];
    else { dtb = inp(F, I_SDTB)[layer * 16 + hd]; aneg = -__expf(inp(F, I_SALOG)[layer * 16 + hd]); dskip = inp(F, I_SD)[layer * 16 + hd]; }
    if (!IS_ML) {
        const float* W = inp(F, I_SCW) + (size_t)layer * 4 * 2048; const float* Bv = inp(F, I_SCB) + (size_t)layer * 2048;
        for (int i = tid; i < 5 * 288; i += NTHR) { const int j = i / 288, c = i - j * 288;
            const int ch = (c < 128) ? 1536 + grp * 128 + c : (c < 256) ? 1024 + grp * 128 + (c - 128) : hd * 64 + sl * 32 + (c - 256);
            cw[i] = (j < 4) ? W[j * 2048 + ch] : Bv[ch]; }
    }
    for (int i = tid; i < 2 * 32 * LDQ / 2; i += NTHR) ((LAS unsigned*)(lds + L_CT))[i] = 0u;
    if (tid < 128) fa[FA_NVEC + tid] = 0.f;
    if (tid == 0) { fa[FA_SC + 1] = 0.f; }
    f32x4 st0 = {0.f, 0.f, 0.f, 0.f}, st1 = {0.f, 0.f, 0.f, 0.f};
    __syncthreads();
    for (int j = 0; j < NCH; ++j) {
        const int r0 = b * PT + 64 * j;
        const int cur = j & 1;
        if (IS_ML) {
#pragma unroll
            for (int i = 0; i < 2; ++i) { const int pc = tid + 512 * i, row = pc >> 4, c16 = pc & 15;
                const bf16* src = F.U + (size_t)(r0 + row) * LDU;
                *(LAS v4u*)(lds + L_QS + (row * LDQ + c16 * 8) * 2) = *(const v4u*)(src + qcol + c16 * 8);
                *(LAS v4u*)(lds + L_KS + (row * LDQ + c16 * 8) * 2) = *(const v4u*)(src + kcol + c16 * 8); }
            if (tid < 256) { const int row = tid >> 2, c = tid & 3; const v4u v = *(const v4u*)(F.U + (size_t)(r0 + row) * LDU + vcol + c * 8);
                LAS bf16* vt = (LAS bf16*)(lds + L_VT);
                vt[(c * 8 + 0) * LDT + row] = (bf16)(v.x & 0xffff); vt[(c * 8 + 1) * LDT + row] = (bf16)(v.x >> 16);
                vt[(c * 8 + 2) * LDT + row] = (bf16)(v.y & 0xffff); vt[(c * 8 + 3) * LDT + row] = (bf16)(v.y >> 16);
                vt[(c * 8 + 4) * LDT + row] = (bf16)(v.z & 0xffff); vt[(c * 8 + 5) * LDT + row] = (bf16)(v.z >> 16);
                vt[(c * 8 + 6) * LDT + row] = (bf16)(v.w & 0xffff); vt[(c * 8 + 7) * LDT + row] = (bf16)(v.w >> 16); }
        } else {
            {
                const int cg = tid & 31, seg = tid >> 5, c0 = cg * 8;
                const int gcol = (c0 < 128) ? qcol + c0 : kcol + (c0 - 128);
                float raw[7][8];
#pragma unroll
                for (int rr = 0; rr < 7; ++rr) { const int row = r0 + seg * 4 - 3 + rr; v4u v = {0u, 0u, 0u, 0u};
                    if (row >= seq0) v = *(const v4u*)(F.U + (size_t)row * LDU + gcol);
                    raw[rr][0] = bflo(v.x); raw[rr][1] = bfhi(v.x); raw[rr][2] = bflo(v.y); raw[rr][3] = bfhi(v.y); raw[rr][4] = bflo(v.z); raw[rr][5] = bfhi(v.z); raw[rr][6] = bflo(v.w); raw[rr][7] = bfhi(v.w); }
                float wv[5][8];
#pragma unroll
                for (int jj = 0; jj < 5; ++jj)
#pragma unroll
                    for (int e = 0; e < 8; ++e) wv[jj][e] = cw[jj * 288 + c0 + e];
#pragma unroll
                for (int q = 0; q < 4; ++q) { float o[8];
#pragma unroll
                    for (int e = 0; e < 8; ++e) { float a = wv[4][e] + wv[0][e] * raw[q][e] + wv[1][e] * raw[q + 1][e] + wv[2][e] * raw[q + 2][e] + wv[3][e] * raw[q + 3][e]; o[e] = siluf_(a); }
                    v4u pk; pk.x = pk2(o[0], o[1]); pk.y = pk2(o[2], o[3]); pk.z = pk2(o[4], o[5]); pk.w = pk2(o[6], o[7]);
                    const int row = seg * 4 + q;
                    *(LAS v4u*)(lds + ((c0 < 128) ? L_QS + (row * LDQ + c0) * 2 : L_KS + (row * LDQ + (c0 - 128)) * 2)) = pk; }
            }
            if (tid < 64) {
                const int cg = tid & 3, seg = tid >> 2, c0 = cg * 8;
                float raw[7][8];
#pragma unroll
                for (int rr = 0; rr < 7; ++rr) { const int row = r0 + seg * 4 - 3 + rr; v4u v = {0u, 0u, 0u, 0u};
                    if (row >= seq0) v = *(const v4u*)(F.U + (size_t)row * LDU + vcol + c0);
                    raw[rr][0] = bflo(v.x); raw[rr][1] = bfhi(v.x); raw[rr][2] = bflo(v.y); raw[rr][3] = bfhi(v.y); raw[rr][4] = bflo(v.z); raw[rr][5] = bfhi(v.z); raw[rr][6] = bflo(v.w); raw[rr][7] = bfhi(v.w); }
                LAS bf16* vt = (LAS bf16*)(lds + L_VT);
#pragma unroll
                for (int q = 0; q < 4; ++q) { const int row = seg * 4 + q;
#pragma unroll
                    for (int e = 0; e < 8; ++e) { const int c = 256 + c0 + e;
                        float a = cw[4 * 288 + c] + cw[c] * raw[q][e] + cw[288 + c] * raw[q + 1][e] + cw[2 * 288 + c] * raw[q + 2][e] + cw[3 * 288 + c] * raw[q + 3][e];
                        a = siluf_(a); vx[row * 32 + c0 + e] = a; vt[(c0 + e) * LDT + row] = (bf16)f2bf(a); } }
            }
        }
        if (w == 7) {
            const int row = r0 + lane; const bool valid = row >= seq0;
            const float* us = F.USM + (size_t)row * USMW;
            const float mprev = fa[FA_SC + 1];
            if (IS_ML) {
                const float li = valid ? us[hd] : -INFINITY;
                const float lf = valid ? logsigmoidf_(us[4 + hd] + fbias) : 0.f;
                const float bc = scan_add(lf, lane);
                const float c = li - bc;
                const float M = fmaxf(mprev, scan_max(c, lane));
                const float M63 = __shfl(M, 63), b63 = __shfl(bc, 63);
                fa[FA_COLV + lane] = c; fa[FA_ROWV + lane] = M; fa[FA_INTER + lane] = __expf(mprev - M); fa[FA_KS + lane] = __expf(c - M63);
                fa[FA_CLAMP + lane] = __expf(-(bc + M));
                if (lane == 0) { fa[FA_SC + 0] = __expf(mprev - M63); fa[FA_SC + 1] = b63 + M63; }
            } else {
                const float dt = valid ? softplusf_(us[8 + hd] + dtb) : 0.f;
                const float cum = scan_add(dt * aneg, lane);
                const float cl = __shfl(cum, 63);
                fa[FA_COLV + lane] = -cum + __logf(dt); fa[FA_ROWV + lane] = -cum; fa[FA_INTER + lane] = __expf(cum); fa[FA_KS + lane] = __expf(cl - cum) * dt;
                if (lane == 0) fa[FA_SC + 0] = __expf(cl);
            }
            fa[FA_DENS + lane] = 0.f; fa[FA_QN + lane] = 0.f;
        }
        __syncthreads();
        {
            const int tt = w >> 1;
#pragma unroll
            for (int h2 = 0; h2 < 2; ++h2) { const int stl = (w & 1) * 2 + h2;
                f32x4 acc = {0.f, 0.f, 0.f, 0.f};
#pragma unroll
                for (int kk = 0; kk < 4; ++kk) acc = MFMA16(ldfrag(lds + L_QS, LDQ, 16 * tt + fr, 32 * kk + 8 * fq), ldfrag(lds + L_KS, LDQ, 16 * stl + fr, 32 * kk + 8 * fq), acc);
                const int sidx = 16 * stl + fr; const float cv = fa[FA_COLV + sidx];
                LAS bf16* ps = (LAS bf16*)(lds + L_PS);
#pragma unroll
                for (int r = 0; r < 4; ++r) { const int t = 16 * tt + 4 * fq + r;
                    float val = (sidx <= t) ? acc[r] * __expf(cv - fa[FA_ROWV + t]) : 0.f;
                    ps[t * LDT + sidx] = (bf16)f2bf(val);
                    if (IS_ML) { val += __shfl_xor(val, 1); val += __shfl_xor(val, 2); val += __shfl_xor(val, 4); val += __shfl_xor(val, 8);
                        if (fr == 0) atomicAdd((float*)(fa + FA_DENS + t), val); } }
            }
            {
                const int sidx = tid & 63, dg = tid >> 6; const float sc = fa[FA_KS + sidx];
                const v4u k0 = *(const LAS v4u*)(lds + L_KS + (sidx * LDQ + dg * 16) * 2), k1 = *(const LAS v4u*)(lds + L_KS + (sidx * LDQ + dg * 16 + 8) * 2);
                LAS bf16* kt = (LAS bf16*)(lds + L_KT) + (dg * 16) * LDT + sidx;
                kt[0 * LDT] = (bf16)f2bf(bflo(k0.x) * sc); kt[1 * LDT] = (bf16)f2bf(bfhi(k0.x) * sc); kt[2 * LDT] = (bf16)f2bf(bflo(k0.y) * sc); kt[3 * LDT] = (bf16)f2bf(bfhi(k0.y) * sc);
                kt[4 * LDT] = (bf16)f2bf(bflo(k0.z) * sc); kt[5 * LDT] = (bf16)f2bf(bfhi(k0.z) * sc); kt[6 * LDT] = (bf16)f2bf(bflo(k0.w) * sc); kt[7 * LDT] = (bf16)f2bf(bfhi(k0.w) * sc);
                kt[8 * LDT] = (bf16)f2bf(bflo(k1.x) * sc); kt[9 * LDT] = (bf16)f2bf(bfhi(k1.x) * sc); kt[10 * LDT] = (bf16)f2bf(bflo(k1.y) * sc); kt[11 * LDT] = (bf16)f2bf(bfhi(k1.y) * sc);
                kt[12 * LDT] = (bf16)f2bf(bflo(k1.z) * sc); kt[13 * LDT] = (bf16)f2bf(bfhi(k1.z) * sc); kt[14 * LDT] = (bf16)f2bf(bflo(k1.w) * sc); kt[15 * LDT] = (bf16)f2bf(bfhi(k1.w) * sc);
            }
            if (IS_ML) {
                const int t = tid & 63, part = tid >> 6; float d = 0.f;
                const LAS bf16* q = (const LAS bf16*)(lds + L_QS) + t * LDQ + part * 16;
#pragma unroll
                for (int e = 0; e < 16; ++e) d += bf2f(q[e]) * fa[FA_NVEC + part * 16 + e];
                atomicAdd((float*)(fa + FA_QN + t), d);
            }
        }
        __syncthreads();
        {
            const int tt = w >> 1, vt2 = w & 1;
            f32x4 apv = {0.f, 0.f, 0.f, 0.f}, aqc = {0.f, 0.f, 0.f, 0.f};
#pragma unroll
            for (int kk = 0; kk < 2; ++kk) apv = MFMA16(ldfrag(lds + L_PS, LDT, 16 * tt + fr, 32 * kk + 8 * fq), ldfrag(lds + L_VT, LDT, 16 * vt2 + fr, 32 * kk + 8 * fq), apv);
#pragma unroll
            for (int kk = 0; kk < 4; ++kk) aqc = MFMA16(ldfrag(lds + L_QS, LDQ, 16 * tt + fr, 32 * kk + 8 * fq), ldfrag(lds + L_CT + cur * 32 * LDQ * 2, LDQ, 16 * vt2 + fr, 32 * kk + 8 * fq), aqc);
            const int vv = 16 * vt2 + fr;
#pragma unroll
            for (int r = 0; r < 4; ++r) { const int t = 16 * tt + 4 * fq + r; const int row = r0 + t;
                const float it = fa[FA_INTER + t]; const float num = apv[r] + it * aqc[r];
                if (row >= seq0) {
                    if (IS_ML) { const float den = fa[FA_DENS + t] + it * fa[FA_QN + t]; const float hv = num / fmaxf(fabsf(den), fa[FA_CLAMP + t]);
                        F.U[(size_t)row * LDU + vcol + vv] = (bf16)f2bf(hv); }
                    else { bf16* zp = F.U + (size_t)row * LDU + zcol + vv; const float z = bf2f(*zp); *zp = (bf16)f2bf((num + dskip * vx[t * 32 + vv]) * siluf_(z)); }
                } }
            const float wc = fa[FA_SC + 0];
            st0 = st0 * wc; st1 = st1 * wc;
#pragma unroll
            for (int kk = 0; kk < 2; ++kk) { const bf16x8 a = ldfrag(lds + L_KT, LDT, 16 * w + fr, 32 * kk + 8 * fq);
                st0 = MFMA16(a, ldfrag(lds + L_VT, LDT, fr, 32 * kk + 8 * fq), st0); st1 = MFMA16(a, ldfrag(lds + L_VT, LDT, 16 + fr, 32 * kk + 8 * fq), st1); }
            LAS unsigned char* ctn = lds + L_CT + (cur ^ 1) * 32 * LDQ * 2;
            { v2u o; o.x = pk2(st0[0], st0[1]); o.y = pk2(st0[2], st0[3]); *(LAS v2u*)(ctn + (fr * LDQ + 16 * w + 4 * fq) * 2) = o;
              o.x = pk2(st1[0], st1[1]); o.y = pk2(st1[2], st1[3]); *(LAS v2u*)(ctn + ((16 + fr) * LDQ + 16 * w + 4 * fq) * 2) = o; }
            if (IS_ML && tid < 128) { float nv = wc * fa[FA_NVEC + tid]; const LAS bf16* kp = (const LAS bf16*)(lds + L_KS) + tid;
#pragma unroll 8
                for (int sidx = 0; sidx < 64; ++sidx) nv += fa[FA_KS + sidx] * bf2f(kp[sidx * LDQ]);
                fa[FA_NVEC + tid] = nv; }
        }
        __syncthreads();
    }
    if (IS_ML) {
        float* pc = F.out + O_PC + (((size_t)(layer * BATCH + b) * 4 + hd) * 128) * 256 + sl * 32;
#pragma unroll
        for (int r = 0; r < 4; ++r) { const int d = 16 * w + 4 * fq + r; pc[(size_t)d * 256 + fr] = st0[r]; pc[(size_t)d * 256 + 16 + fr] = st1[r]; }
        if (sl == 0) { if (tid < 128) F.out[O_PN + ((size_t)(layer * BATCH + b) * 4 + hd) * 128 + tid] = fa[FA_NVEC + tid];
            if (tid == 0) F.out[O_PM + (layer * BATCH + b) * 4 + hd] = fa[FA_SC + 1]; }
    } else {
        float* ph = F.out + O_PHS + (((size_t)(layer * BATCH + b) * 16 + hd) * 64 + sl * 32) * 128;
        *(f32x4*)(ph + (size_t)fr * 128 + 16 * w + 4 * fq) = st0; *(f32x4*)(ph + (size_t)(16 + fr) * 128 + 16 * w + 4 * fq) = st1;
    }
    __syncthreads();
}
constexpr int L_XB = 0, L_XF = 9216, L_WA = 25600, L_WX = 30208, L_AA = 34816, L_UU = 43008, L_SA = 51200, L_SU = 53248, L_HP = 55296;
__device__ __forceinline__ void lru_prompt_item(Frame& F, int layer, int item) {
    const int tid = F.tid, lane = F.lane, w = F.wave, fr = lane & 15, fq = lane >> 4;
    LAS unsigned char* lds = F.lds;
    const int b = item >> 5, blk = (item >> 1) & 15, half = item & 1;
    const int seq0 = ROW0 + b * PT, ch0 = blk * 64;
    LAS float* xf = (LAS float*)(lds + L_XF); LAS float* aa = (LAS float*)(lds + L_AA); LAS float* uu = (LAS float*)(lds + L_UU);
    LAS float* sa = (LAS float*)(lds + L_SA); LAS float* su = (LAS float*)(lds + L_SU); LAS float* hp = (LAS float*)(lds + L_HP);
    {
        const int e = tid >> 3, c = tid & 7;
        const int ax = e >> 5, el = e & 31;
        const bf16* src = F.WLRU + ((((size_t)layer * 2 + ax) * 16 + blk) * 64 + half * 32 + el) * 64 + c * 8;
        *(LAS v4u*)(lds + (ax ? L_WX : L_WA) + (el * LDT + c * 8) * 2) = *(const v4u*)src;
    }
    if (tid < 64) hp[tid] = 0.f;
    const int cgc = tid & 7, crow = tid >> 3;
    float cwv[5][8];
    { const float* W = inp(F, I_LCW) + (size_t)layer * 4 * 1024 + ch0 + cgc * 8; const float* Bv = inp(F, I_LCB) + (size_t)layer * 1024 + ch0 + cgc * 8;
#pragma unroll
      for (int e = 0; e < 8; ++e) { cwv[0][e] = W[e]; cwv[1][e] = W[1024 + e]; cwv[2][e] = W[2048 + e]; cwv[3][e] = W[3072 + e]; cwv[4][e] = Bv[e]; } }
    const int ech = 16 * (w & 1) + fr, chn = ch0 + half * 32 + ech;
    const float ba = inp(F, I_LBA)[layer * 1024 + chn], bx = inp(F, I_LBX)[layer * 1024 + chn];
    const float spl = softplusf_(-inp(F, I_LLAM)[layer * 1024 + chn]);
    __syncthreads();
    for (int j = 0; j < NCH; ++j) {
        const int r0 = b * PT + 64 * j, cur = j & 1;
        {
            float acc[8];
#pragma unroll
            for (int e = 0; e < 8; ++e) acc[e] = cwv[4][e];
#pragma unroll
            for (int jj = 0; jj < 4; ++jj) { const int row = r0 + crow - 3 + jj; v4u v = {0u, 0u, 0u, 0u};
                if (row >= seq0) v = *(const v4u*)(F.U + (size_t)row * LDU + C_LX + ch0 + cgc * 8);
                acc[0] += cwv[jj][0] * bflo(v.x); acc[1] += cwv[jj][1] * bfhi(v.x); acc[2] += cwv[jj][2] * bflo(v.y); acc[3] += cwv[jj][3] * bfhi(v.y);
                acc[4] += cwv[jj][4] * bflo(v.z); acc[5] += cwv[jj][5] * bfhi(v.z); acc[6] += cwv[jj][6] * bflo(v.w); acc[7] += cwv[jj][7] * bfhi(v.w); }
            v4u pk; pk.x = pk2(acc[0], acc[1]); pk.y = pk2(acc[2], acc[3]); pk.z = pk2(acc[4], acc[5]); pk.w = pk2(acc[6], acc[7]);
            *(LAS v4u*)(lds + L_XB + (crow * LDT + cgc * 8) * 2) = pk;
#pragma unroll
            for (int e = 0; e < 8; ++e) xf[crow * 64 + cgc * 8 + e] = acc[e];
        }
        __syncthreads();
        {
            const int tt = w >> 1;
            f32x4 ga = {0.f, 0.f, 0.f, 0.f}, gx = {0.f, 0.f, 0.f, 0.f};
#pragma unroll
            for (int kk = 0; kk < 2; ++kk) { const bf16x8 a = ldfrag(lds + L_XB, LDT, 16 * tt + fr, 32 * kk + 8 * fq);
                ga = MFMA16(a, ldfrag(lds + L_WA, LDT, 16 * (w & 1) + fr, 32 * kk + 8 * fq), ga); gx = MFMA16(a, ldfrag(lds + L_WX, LDT, 16 * (w & 1) + fr, 32 * kk + 8 * fq), gx); }
#pragma unroll
            for (int r = 0; r < 4; ++r) { const int t = 16 * tt + 4 * fq + r; const bool valid = (r0 + t) >= seq0;
                const float rg = sigmoidf_(ga[r] + ba), ig = sigmoidf_(gx[r] + bx);
                const float la = -8.0f * rg * spl; const float av = __expf(la);
                const float uv = sqrtf(fmaxf(1.0f - __expf(2.0f * la), 0.f)) * (ig * xf[t * 64 + half * 32 + ech]);
                aa[t * 32 + ech] = valid ? av : 1.0f; uu[t * 32 + ech] = valid ? uv : 0.f; }
        }
        __syncthreads();
        const int e = tid & 31, seg = tid >> 5;
        float a4[4], u4[4];
        { float A = 1.f, Ua = 0.f;
#pragma unroll
          for (int i = 0; i < 4; ++i) { a4[i] = aa[(seg * 4 + i) * 32 + e]; u4[i] = uu[(seg * 4 + i) * 32 + e]; A = a4[i] * A; Ua = a4[i] * Ua + u4[i]; }
          sa[seg * 32 + e] = A; su[seg * 32 + e] = Ua; }
        __syncthreads();
        { float h = hp[cur * 32 + e];
          for (int s2 = 0; s2 < seg; ++s2) h = sa[s2 * 32 + e] * h + su[s2 * 32 + e];
          const int chz = C_LZ + ch0 + half * 32 + e;
#pragma unroll
          for (int i = 0; i < 4; ++i) { h = a4[i] * h + u4[i]; const int row = r0 + seg * 4 + i;
              if (row >= seq0) { bf16* zp = F.U + (size_t)row * LDU + chz; *zp = (bf16)f2bf(h * siluf_(bf2f(*zp))); } }
          if (seg == 15) hp[(cur ^ 1) * 32 + e] = h; }
        __syncthreads();
    }
    if (tid < 32) F.out[O_PHL + (size_t)(layer * BATCH + b) * 1024 + ch0 + half * 32 + tid] = hp[(NCH & 1) * 32 + tid];
    __syncthreads();
}

__device__ __forceinline__ float scan8_add(float x, int l8) {
#pragma unroll
    for (int o = 1; o < 8; o <<= 1) { const float t = __shfl_up(x, o, 8); if (l8 >= o) x += t; }
    return x;
}
__device__ __forceinline__ float scan8_max(float x, int l8) {
#pragma unroll
    for (int o = 1; o < 8; o <<= 1) { const float t = __shfl_up(x, o, 8); if (l8 >= o) x = fmaxf(x, t); }
    return x;
}
constexpr int S_QS = 0, S_KR = 4096, S_KW = 8192, S_NV = 12288, S_G = 12800, S_PM = 13312, S_QCS = 13568;
__device__ __forceinline__ void mlstm_sample_item(Frame& F, int layer, int item) {
    const int tid = F.tid, lane = F.lane, w = F.wave;
    const int b = item >> 2, hd = item & 3;
    LAS float* qs = (LAS float*)(F.lds + S_QS); LAS float* kr = (LAS float*)(F.lds + S_KR); LAS float* kw = (LAS float*)(F.lds + S_KW);
    LAS float* nv = (LAS float*)(F.lds + S_NV); LAS float* g = (LAS float*)(F.lds + S_G); LAS float* pm = (LAS float*)(F.lds + S_PM); LAS float* qcs = (LAS float*)(F.lds + S_QCS);
    const int row0 = SROW0 + b * DECS;
    const size_t sidx = (size_t)(layer * DECB + b) * 4 + hd;
#pragma unroll
    for (int i = 0; i < 2; ++i) { const int idx = tid + 512 * i, t = idx >> 7, d = idx & 127; const bf16* ur = F.U + (size_t)(row0 + t) * LDU;
        qs[d * 8 + t] = bf2f(ur[C_Q + hd * 128 + d]); kr[d * 8 + t] = bf2f(ur[C_K + hd * 128 + d]); }
    if (tid < 128) nv[tid] = inp(F, I_SN)[sidx * 128 + tid];
    if (w == 7 && lane < 8) {
        const float* us = F.USM + (size_t)(row0 + lane) * USMW;
        const float m0 = inp(F, I_SM)[sidx];
        const float li = us[hd], lf = logsigmoidf_(us[4 + hd] + inp(F, I_FBIAS)[layer * 4 + hd]);
        const float bc = scan8_add(lf, lane), c = li - bc, M = fmaxf(m0, scan8_max(c, lane));
        const float M7 = __shfl(M, 7, 8), b7 = __shfl(bc, 7, 8);
        g[lane] = c; g[8 + lane] = M; g[16 + lane] = __expf(m0 - M); g[24 + lane] = __expf(c - M7); g[32 + lane] = __expf(-(bc + M));
        if (lane == 0) { g[56] = __expf(m0 - M7); g[57] = b7 + M7; }
    }
    __syncthreads();
    if (w == 0) {
        const int t = lane >> 3, sx = lane & 7; float d = 0.f;
        for (int dd = 0; dd < 128; ++dd) d += qs[dd * 8 + t] * kr[dd * 8 + sx];
        float val = (sx <= t) ? d * __expf(g[sx] - g[8 + t]) : 0.f;
        pm[t * 8 + sx] = val;
        val += __shfl_xor(val, 1); val += __shfl_xor(val, 2); val += __shfl_xor(val, 4);
        if (sx == 0) g[40 + t] = val;
    } else if (w == 1) {
        const int t = lane >> 3, part = lane & 7; float d = 0.f;
        for (int dd = part * 16; dd < part * 16 + 16; ++dd) d += qs[dd * 8 + t] * nv[dd];
        d += __shfl_xor(d, 1); d += __shfl_xor(d, 2); d += __shfl_xor(d, 4);
        if (part == 0) g[48 + t] = d;
    }
#pragma unroll
    for (int i = 0; i < 2; ++i) { const int idx = tid + 512 * i; kw[idx] = kr[idx] * g[24 + (idx & 7)]; }
    __syncthreads();
    const int v = tid & 255, dh = tid >> 8;
    float vv[8], qc[8];
#pragma unroll
    for (int t = 0; t < 8; ++t) { vv[t] = bf2f(F.U[(size_t)(row0 + t) * LDU + C_V + hd * 256 + v]); qc[t] = 0.f; }
    {
        const float wc = g[56];
        const float* c0 = inp(F, I_SC) + sidx * 128 * 256 + v; float* c1 = F.out + O_SC + sidx * 128 * 256 + v;
#pragma unroll 4
        for (int d = dh * 64; d < dh * 64 + 64; ++d) {
            const float cval = c0[(size_t)d * 256];
            const f32x4 q0 = *(const LAS f32x4*)(qs + d * 8), q1 = *(const LAS f32x4*)(qs + d * 8 + 4), k0 = *(const LAS f32x4*)(kw + d * 8), k1 = *(const LAS f32x4*)(kw + d * 8 + 4);
            qc[0] += q0.x * cval; qc[1] += q0.y * cval; qc[2] += q0.z * cval; qc[3] += q0.w * cval; qc[4] += q1.x * cval; qc[5] += q1.y * cval; qc[6] += q1.z * cval; qc[7] += q1.w * cval;
            c1[(size_t)d * 256] = wc * cval + (k0.x * vv[0] + k0.y * vv[1] + k0.z * vv[2] + k0.w * vv[3]) + (k1.x * vv[4] + k1.y * vv[5] + k1.z * vv[6] + k1.w * vv[7]);
        }
    }
#pragma unroll
    for (int t = 0; t < 8; ++t) qcs[(dh * 8 + t) * 256 + v] = qc[t];
    __syncthreads();
#pragma unroll
    for (int i = 0; i < 4; ++i) { const int t = dh * 4 + i; const float QC = qcs[t * 256 + v] + qcs[(8 + t) * 256 + v];
        float pv = 0.f;
#pragma unroll
        for (int sx = 0; sx < 8; ++sx) pv += pm[t * 8 + sx] * vv[sx];
        const float it = g[16 + t]; const float num = pv + it * QC, den = g[40 + t] + it * g[48 + t];
        F.U[(size_t)(row0 + t) * LDU + C_V + hd * 256 + v] = (bf16)f2bf(num / fmaxf(fabsf(den), g[32 + t])); }
    if (tid < 128) { float nn = g[56] * nv[tid];
#pragma unroll
        for (int sx = 0; sx < 8; ++sx) nn += kw[tid * 8 + sx];
        F.out[O_SN + sidx * 128 + tid] = nn; }
    if (tid == 0) F.out[O_SM + sidx] = g[57];
    __syncthreads();
}

constexpr int T_BC = 0, T_CC = 4096, T_G = 8192, T_XS = 8448, T_H = 10496, T_W = 10752, T_SL = 11008;
__device__ __forceinline__ float ssd_conv_sample(Frame& F, int layer, int b, int row0, int t, int ch, const float* W, const float* Bv) {
    float a = Bv[ch];
#pragma unroll
    for (int jj = 0; jj < 4; ++jj) { const int tp = t - 3 + jj;
        const float raw = (tp >= 0) ? bf2f(F.U[(size_t)(row0 + tp) * LDU + C_XBC + ch]) : inp(F, I_SCS)[((size_t)(layer * DECB + b) * 3 + (3 + tp)) * 2048 + ch];
        a += W[jj * 2048 + ch] * raw; }
    return siluf_(a);
}
__device__ __forceinline__ void ssd_sample_item(Frame& F, int layer, int item) {
    const int tid = F.tid, lane = F.lane, w = F.wave;
    const int b = item >> 2, grp = item & 3, row0 = SROW0 + b * DECS;
    LAS float* Bc = (LAS float*)(F.lds + T_BC); LAS float* Cc = (LAS float*)(F.lds + T_CC); LAS float* G = (LAS float*)(F.lds + T_G);
    LAS float* xs = (LAS float*)(F.lds + T_XS); LAS float* hv = (LAS float*)(F.lds + T_H); LAS float* Wm = (LAS float*)(F.lds + T_W); LAS float* Sl = (LAS float*)(F.lds + T_SL);
    const float* W = inp(F, I_SCW) + (size_t)layer * 4 * 2048; const float* Bv = inp(F, I_SCB) + (size_t)layer * 2048;
#pragma unroll
    for (int i = 0; i < 4; ++i) { const int idx = tid + 512 * i, which = idx >> 10, t = (idx >> 7) & 7, n = idx & 127;
        const float val = ssd_conv_sample(F, layer, b, row0, t, 1024 + which * 512 + grp * 128 + n, W, Bv);
        if (which) Cc[t * 128 + n] = val; else Bc[t * 128 + n] = val; }
    __syncthreads();
    if (w == 0) { const int t = lane >> 3, sx = lane & 7; float d = 0.f;
        for (int n = 0; n < 128; ++n) d += Cc[t * 128 + n] * Bc[sx * 128 + n];
        G[t * 8 + sx] = d; }
    for (int e4 = 0; e4 < 4; ++e4) {
        const int hd = grp * 4 + e4;
        const size_t sidx = (size_t)(layer * DECB + b) * 16 + hd;
        { const int t = tid >> 6, pp = tid & 63; xs[t * 64 + pp] = ssd_conv_sample(F, layer, b, row0, t, hd * 64 + pp, W, Bv); }
        if (w == 7 && lane < 8) {
            const float dt = softplusf_(F.USM[(size_t)(row0 + lane) * USMW + 8 + hd] + inp(F, I_SDTB)[layer * 16 + hd]);
            const float aneg = -__expf(inp(F, I_SALOG)[layer * 16 + hd]);
            const float cum = scan8_add(dt * aneg, lane), cl = __shfl(cum, 7, 8);
            hv[lane] = cum; hv[8 + lane] = dt; hv[16 + lane] = __expf(cum); hv[24 + lane] = __expf(cl - cum) * dt;
            if (lane == 0) hv[32] = __expf(cl);
        }
        { const float* s0 = inp(F, I_SHS) + sidx * 64 * 128;
#pragma unroll
          for (int i = 0; i < 4; ++i) { const int idx4 = tid + 512 * i, pp = idx4 >> 5, n4 = idx4 & 31; const f32x4 v = *(const f32x4*)(s0 + pp * 128 + n4 * 4);
              LAS float* d = Sl + pp * 129 + n4 * 4; d[0] = v.x; d[1] = v.y; d[2] = v.z; d[3] = v.w; } }
        __syncthreads();
        if (w == 0) { const int t = lane >> 3, sx = lane & 7; Wm[t * 8 + sx] = (sx <= t) ? G[t * 8 + sx] * __expf(hv[t] - hv[sx]) * hv[8 + sx] : 0.f; }
        float ycs = 0.f;
        { const int t = tid >> 6, pp = tid & 63;
          for (int n = 0; n < 128; ++n) ycs += Cc[t * 128 + n] * Sl[pp * 129 + n]; }
        __syncthreads();
        { const int t = tid >> 6, pp = tid & 63; float y = hv[16 + t] * ycs;
#pragma unroll
          for (int sx = 0; sx < 8; ++sx) y += Wm[t * 8 + sx] * xs[sx * 64 + pp];
          bf16* zp = F.U + (size_t)(row0 + t) * LDU + C_SZ + hd * 64 + pp;
          *zp = (bf16)f2bf((y + inp(F, I_SD)[layer * 16 + hd] * xs[t * 64 + pp]) * siluf_(bf2f(*zp))); }
        { const int n = tid & 127, pq = tid >> 7; const float wc = hv[32]; float bn[8];
#pragma unroll
          for (int sx = 0; sx < 8; ++sx) bn[sx] = Bc[sx * 128 + n] * hv[24 + sx];
          float* s1 = F.out + O_SHS + sidx * 64 * 128;
          for (int pp = pq * 16; pp < pq * 16 + 16; ++pp) { float sn = wc * Sl[pp * 129 + n];
#pragma unroll
              for (int sx = 0; sx < 8; ++sx) sn += xs[sx * 64 + pp] * bn[sx];
              s1[pp * 128 + n] = sn; } }
        __syncthreads();
    }
}

__device__ __forceinline__ void lru_sample_item(Frame& F, int layer, int item) {
    const int tid = F.tid;
    const int b = item >> 1, half = item & 1, ch = half * 512 + tid, row0 = SROW0 + b * DECS, blk = ch >> 6, e = ch & 63;
    LAS float* xcs = (LAS float*)F.lds;
    float xc[8];
    { const float* W = inp(F, I_LCW) + (size_t)layer * 4 * 1024; const float bias = inp(F, I_LCB)[layer * 1024 + ch];
      float raw[11];
#pragma unroll
      for (int i = 0; i < 3; ++i) raw[i] = inp(F, I_SCL)[((size_t)(layer * DECB + b) * 3 + i) * 1024 + ch];
#pragma unroll
      for (int t = 0; t < 8; ++t) raw[3 + t] = bf2f(F.U[(size_t)(row0 + t) * LDU + C_LX + ch]);
      const float w0 = W[ch], w1 = W[1024 + ch], w2 = W[2048 + ch], w3 = W[3072 + ch];
#pragma unroll
      for (int t = 0; t < 8; ++t) { xc[t] = bias + w0 * raw[t] + w1 * raw[t + 1] + w2 * raw[t + 2] + w3 * raw[t + 3]; xcs[t * 512 + tid] = xc[t]; } }
    __syncthreads();
    float ra[8], rx[8];
#pragma unroll
    for (int t = 0; t < 8; ++t) { ra[t] = 0.f; rx[t] = 0.f; }
    { const float* wa = inp(F, I_LWA) + ((size_t)layer * 16 + blk) * 4096 + e; const float* wx = inp(F, I_LWX) + ((size_t)layer * 16 + blk) * 4096 + e;
      const int xb = (tid & ~63);
      for (int d = 0; d < 64; ++d) { const float a = wa[d * 64], x = wx[d * 64];
#pragma unroll
          for (int t = 0; t < 8; ++t) { const float xv = xcs[t * 512 + xb + d]; ra[t] += xv * a; rx[t] += xv * x; } } }
    const float ba = inp(F, I_LBA)[layer * 1024 + ch], bx = inp(F, I_LBX)[layer * 1024 + ch], spl = softplusf_(-inp(F, I_LLAM)[layer * 1024 + ch]);
    float h = inp(F, I_SHL)[(size_t)(layer * DECB + b) * 1024 + ch];
#pragma unroll
    for (int t = 0; t < 8; ++t) { const float rg = sigmoidf_(ra[t] + ba), ig = sigmoidf_(rx[t] + bx); const float la = -8.0f * rg * spl;
        h = __expf(la) * h + sqrtf(fmaxf(1.0f - __expf(2.0f * la), 0.f)) * (ig * xc[t]);
        bf16* zp = F.U + (size_t)(row0 + t) * LDU + C_LZ + ch; *zp = (bf16)f2bf(h * siluf_(bf2f(*zp))); }
    F.out[O_SHL + (size_t)(layer * DECB + b) * 1024 + ch] = h;
    __syncthreads();
}

#if defined(DBG_TIMING) && DBG_TIMING == 2
#define DBG_STAMP(i) do { if (F.tid == 0) ((volatile LAS unsigned long long*)(F.lds + LDSCTL_OFF + 768))[i] = __builtin_amdgcn_s_memrealtime(); } while (0)
#else
#define DBG_STAMP(i) do { } while (0)
#endif
__device__ __forceinline__ void scan_phase(Frame& F, int layer) {
    if (layer == 0) DBG_STAMP(0);
    for (int it = F.vcu; it < 256; it += F.G) chunk_scan_item<true>(F, layer, it);
    if (layer == 0) DBG_STAMP(1);
    for (int it = F.vcu; it < 256; it += F.G) chunk_scan_item<false>(F, layer, it);
    if (layer == 0) DBG_STAMP(2);
    for (int it = F.vcu; it < 256; it += F.G) lru_prompt_item(F, layer, it);
    if (layer == 0) DBG_STAMP(3);
    for (int it = F.vcu; it < DECB * 4; it += F.G) mlstm_sample_item(F, layer, it);
    if (layer == 0) DBG_STAMP(4);
    for (int it = F.vcu; it < DECB * 4; it += F.G) ssd_sample_item(F, layer, it);
    if (layer == 0) DBG_STAMP(5);
    for (int it = F.vcu; it < DECB * 2; it += F.G) lru_sample_item(F, layer, it);
    if (layer == 0) DBG_STAMP(6);
}
__device__ __forceinline__ void gate_phase(Frame& F, int layer) {
    const int lane = F.lane;
    float g1[16], g2[16];
    { const float* p1 = inp(F, I_MLNG) + layer * 1024 + 16 * lane; const float* p2 = inp(F, I_SNG) + layer * 1024 + 16 * lane;
#pragma unroll
      for (int e = 0; e < 16; ++e) { g1[e] = p1[e]; g2[e] = p2[e]; } }
    const int gw = F.vcu * NWAVES + F.wave, NGW = F.G * NWAVES;
    for (int row = ROW0 + gw; row < RTOK; row += NGW) {
        bf16* ur = F.U + (size_t)row * LDU + 16 * lane;
        float h[16], o[16], z[16];
        unpack16(*(const v4u*)(ur + C_V), *(const v4u*)(ur + C_V + 8), h);
        unpack16(*(const v4u*)(ur + C_O), *(const v4u*)(ur + C_O + 8), o);
        unpack16(*(const v4u*)(ur + C_Z), *(const v4u*)(ur + C_Z + 8), z);
        float ss = 0.f;
#pragma unroll
        for (int e = 0; e < 16; ++e) ss += h[e] * h[e];
        ss += __shfl_xor(ss, 1); ss += __shfl_xor(ss, 2); ss += __shfl_xor(ss, 4); ss += __shfl_xor(ss, 8);
        const float rs = 1.0f / sqrtf(ss * (1.f / 256.f) + EPS);
#pragma unroll
        for (int e = 0; e < 16; ++e) h[e] = h[e] * rs * g1[e] * sigmoidf_(o[e]) * siluf_(z[e]);
        v4u a, b2; a.x = pk2(h[0], h[1]); a.y = pk2(h[2], h[3]); a.z = pk2(h[4], h[5]); a.w = pk2(h[6], h[7]); b2.x = pk2(h[8], h[9]); b2.y = pk2(h[10], h[11]); b2.z = pk2(h[12], h[13]); b2.w = pk2(h[14], h[15]);
        *(v4u*)(ur + C_V) = a; *(v4u*)(ur + C_V + 8) = b2;
        unpack16(*(const v4u*)(ur + C_SZ), *(const v4u*)(ur + C_SZ + 8), h);
        float s2 = 0.f;
#pragma unroll
        for (int e = 0; e < 16; ++e) s2 += h[e] * h[e];
        const float rs2 = 1.0f / sqrtf(wave_sum(s2) * (1.f / 1024.f) + EPS);
#pragma unroll
        for (int e = 0; e < 16; ++e) h[e] = h[e] * rs2 * g2[e];
        a.x = pk2(h[0], h[1]); a.y = pk2(h[2], h[3]); a.z = pk2(h[4], h[5]); a.w = pk2(h[6], h[7]); b2.x = pk2(h[8], h[9]); b2.y = pk2(h[10], h[11]); b2.z = pk2(h[12], h[13]); b2.w = pk2(h[14], h[15]);
        *(v4u*)(ur + C_SZ) = a; *(v4u*)(ur + C_SZ + 8) = b2;
    }
}
__device__ __forceinline__ void final_norm_phase(Frame& F) {
    const float* g = inp(F, I_FNG);
    f32x4 gv[4];
#pragma unroll
    for (int j = 0; j < 4; ++j) gv[j] = *(const f32x4*)(g + 4 * F.lane + 256 * j);
    const int gw = F.vcu * NWAVES + F.wave, NGW = F.G * NWAVES;
    for (int i = gw; i < BATCH * SEQ + SROWS; i += NGW) {
        float* xr = F.out + (size_t)i * DM;
        f32x4 v[4]; float s = 0.f;
#pragma unroll
        for (int j = 0; j < 4; ++j) { v[j] = *(const f32x4*)(xr + 4 * F.lane + 256 * j); s += (v[j].x * v[j].x + v[j].y * v[j].y) + (v[j].z * v[j].z + v[j].w * v[j].w); }
        const float rstd = 1.0f / sqrtf(wave_sum(s) * (1.f / DM) + EPS);
#pragma unroll
        for (int j = 0; j < 4; ++j) *(f32x4*)(xr + 4 * F.lane + 256 * j) = v[j] * rstd * gv[j];
    }
}

__global__ void __launch_bounds__(NTHR, 2) fwd_kernel(Args args) {
    extern __shared__ __attribute__((aligned(16))) unsigned char lds[];
    Frame F;
    F.lds = (LAS unsigned char*)lds;
    F.MISC = (volatile LAS unsigned*)(F.lds + MISC_OFF);
    F.tid = threadIdx.x; F.lane = F.tid & 63; F.wave = __builtin_amdgcn_readfirstlane(F.tid >> 6);
    F.G = gridDim.x; { const int bx = blockIdx.x; F.vcu = (F.G % 8 == 0) ? (bx % 8) * (F.G / 8) + bx / 8 : bx; }
    unsigned char* ws = args.ws; F.ws = ws; F.out = args.out;
    F.ctl = (gu32*)(ws + WS_CTL);
    F.U = (bf16*)(ws + WS_U); F.USM = (float*)(ws + WS_USM); F.XN = (bf16*)(ws + WS_XN); F.WIN = (bf16*)(ws + WS_WIN); F.WBR = (bf16*)(ws + WS_WBR);
    F.WOUT = (bf16*)(ws + WS_WOUT); F.WLRU = (bf16*)(ws + WS_WLRU); F.XAUX = (float*)(ws + WS_XAUX);
    for (int u = F.tid; u < (LDS_BYTES - LDSCTL_OFF) / 4; u += NTHR) ((LAS unsigned*)(F.lds + LDSCTL_OFF))[u] = 0u;
    __syncthreads();
    if (F.tid == 0) {
        LAS unsigned long long* t = (LAS unsigned long long*)(F.lds + PTR_OFF);
#pragma unroll
        for (int i = 0; i < 32; ++i) t[i] = (unsigned long long)args.in[i];
    }
    __syncthreads();
    XcdBarrier bar; bar.bar = (unsigned*)(F.ctl + CW_BAR); bar.x = 0; bar.st = nullptr;
    if (N_LAUNCHES == 1) bar = xcd_barrier_post((unsigned*)(F.ctl + CW_BAR), F.MISC + 8);
#define GRID_BAR() do { if (N_LAUNCHES == 1) xcd_barrier(bar); } while (0)
    const int lo = args.ph_lo, hi = args.ph_hi;
#define IN(k) (lo <= (k) && (k) < hi)
#ifdef DBG_TIMING
    volatile LAS unsigned long long* tsl = (volatile LAS unsigned long long*)(F.lds + LDSCTL_OFF + 768);
#if DBG_TIMING == 1
    GRID_BAR(); if (F.tid == 0) tsl[0] = __builtin_amdgcn_s_memrealtime();
#define SEAM(k) do { GRID_BAR(); if (F.tid == 0) tsl[(k) + 1] = __builtin_amdgcn_s_memrealtime(); } while (0)
#else
#define SEAM(k) do { GRID_BAR(); } while (0)
#endif
#else
#define SEAM(k) do { if (IN(k) && IN((k) + 1)) GRID_BAR(); } while (0)
#endif
    if (IN(0)) {
        LAS float* scr = (LAS float*)(F.lds + F.wave * 16384);
        const int gw = F.vcu * NWAVES + F.wave, NGW = F.G * NWAVES;
        for (int it = gw; it < WIN_ITEMS + WSQ_ITEMS + WLRU_ITEMS; it += NGW) {
            if (it < WIN_ITEMS) win_item(F, 0, it, scr);
            else if (it < WIN_ITEMS + WSQ_ITEMS) wsq_item(F, it - WIN_ITEMS, scr);
            else wlru_item(F, it - WIN_ITEMS - WSQ_ITEMS, scr);
        }
        __syncthreads();
        norm_rows(F, 0);
    }
    SEAM(0);
#define LAYER_PHASES(LYR, base) \
    if (IN((base) + 0)) { pg8::Gemm g{(const char*)F.XN, DM, (const char*)F.WIN, DM}; SchedIn S; S.T.init(R / 256, NBIG / 256, F.G, (int)blockIdx.x); \
        EpiU E{F.U}; pg8::gemm_phase<EpiU, SchedIn>(F.lds, g, S, E); } \
    SEAM((base) + 0); \
    if (IN((base) + 1)) { scan_phase(F, LYR); conv_state_out(F, LYR); \
        if ((LYR) == 0) { __syncthreads(); LAS float* scr = (LAS float*)(F.lds + F.wave * 16384); const int gw = F.vcu * NWAVES + F.wave, NGW = F.G * NWAVES; \
            for (int it = gw; it < WIN_ITEMS; it += NGW) win_item(F, 1, it, scr); } } \
    SEAM((base) + 1); \
    if (IN((base) + 2)) { gate_phase(F, LYR); } \
    SEAM((base) + 2); \
    if (IN((base) + 3)) { pg8::Gemm g{(const char*)F.U, LDU, (const char*)F.WBR, DM}; SchedBr S; S.T.init(R / 256, DM / 256, F.G, (int)blockIdx.x); S.layer = LYR; \
        EpiBr E{F.U, F.XN}; pg8::gemm_phase<EpiBr, SchedBr>(F.lds, g, S, E); } \
    SEAM((base) + 3); \
    if (IN((base) + 4)) { pg8::Gemm g{(const char*)F.XN, DM, (const char*)F.WOUT, DM}; SchedOut S; S.T.init(R / 256, DM / 256, F.G, (int)blockIdx.x); S.layer = LYR; \
        EpiOut E{&F, F.out, F.XAUX, LYR}; pg8::gemm_phase<EpiOut, SchedOut>(F.lds, g, S, E); } \
    SEAM((base) + 4);
    LAYER_PHASES(0, 1)
    if (IN(6)) norm_rows(F, 1);
    SEAM(6);
    LAYER_PHASES(1, 7)
    if (IN(12)) final_norm_phase(F);
#ifdef DBG_TIMING
    SEAM(12);
    if (blockIdx.x == 0) {
        __syncthreads();
        const size_t offs[13] = {O_PC, O_PN, O_PHL, O_PCL, O_PHS, O_PCS, O_SC, O_SN, O_SHL, O_SCL, O_SHS, O_SCS, O_YP};
#pragma unroll
        for (int k = 0; k < 13; ++k) { const unsigned us = (unsigned)((tsl[k + 1] - tsl[k]) / 100ull);
            for (unsigned i = F.tid; i < us && i < 8000u; i += NTHR) ((unsigned*)F.out)[offs[k] + i] = 0xAAAAAAAAu; }
    }
#endif
#undef IN
#undef SEAM
}

extern "C" void kernel_launch(void* const* d_in, const int* in_sizes, int n_in, void* d_out, int out_size, void* d_ws, size_t ws_size, hipStream_t stream) {
    static int grid = 0;
    if (grid == 0) {
        int dev = 0, cus = 0, per_cu = 0;
        if (hipGetDevice(&dev) != hipSuccess || hipDeviceGetAttribute(&cus, hipDeviceAttributeMultiprocessorCount, dev) != hipSuccess) { fprintf(stderr, "kernel_launch: device query failed\n"); grid = -1; return; }
        if (hipFuncSetAttribute((const void*)fwd_kernel, hipFuncAttributeMaxDynamicSharedMemorySize, LDS_BYTES) != hipSuccess) { fprintf(stderr, "kernel_launch: hipFuncSetAttribute failed\n"); grid = -1; return; }
        if (hipOccupancyMaxActiveBlocksPerMultiprocessor(&per_cu, (const void*)fwd_kernel, NTHR, LDS_BYTES) != hipSuccess || per_cu < 1) { fprintf(stderr, "kernel_launch: occupancy query says %d blocks per CU\n", per_cu); }
        (void)hipGetLastError();
        grid = cus;
        if (ws_size < WS_END) fprintf(stderr, "kernel_launch: workspace too small: %zu < %zu\n", ws_size, (size_t)WS_END);
        if (n_in != 32 || (size_t)out_size != O_END) fprintf(stderr, "kernel_launch: unexpected n_in %d / out_size %d (want 32 / %zu)\n", n_in, out_size, (size_t)O_END);
    }
    if (grid < 0) return;
    (void)in_sizes;
    if (hipMemsetAsync((char*)d_ws + WS_CTL, 0, CTL_ZERO_BYTES, stream) != hipSuccess) { fprintf(stderr, "kernel_launch: memset failed\n"); return; }
    Args a{};
    for (int i = 0; i < 32; ++i) a.in[i] = (const float*)d_in[i];
    a.out = (float*)d_out; a.ws = (unsigned char*)d_ws;
    for (int li = 0; li < N_LAUNCHES; ++li) {
        if (N_LAUNCHES == 1) { a.ph_lo = 0; a.ph_hi = N_PHASES; } else { a.ph_lo = li; a.ph_hi = li + 1; }
        a.li = li;
        hipLaunchKernelGGL(fwd_kernel, dim3(grid), dim3(NTHR), LDS_BYTES, stream, a);
        const hipError_t le = hipPeekAtLastError();
        if (le != hipSuccess) { fprintf(stderr, "kernel_launch: launch %d failed: %s\n", li, hipGetErrorName(le)); break; }
    }
}
```

```cpp
#include <hip/hip_runtime.h>
#include <cstdio>
#include <cstdint>

#ifndef MK_N_LAUNCHES
#define MK_N_LAUNCHES 1
#endif

namespace pg8 {
#define PG8_LAS __attribute__((address_space(3)))
typedef unsigned short bf16_t;
typedef short bf16x8 __attribute__((ext_vector_type(8)));
typedef float f32x4 __attribute__((ext_vector_type(4)));
typedef unsigned u32x4 __attribute__((ext_vector_type(4)));
typedef unsigned u32x2 __attribute__((ext_vector_type(2)));
constexpr int BM = 256, BK = 64, HALF = 128, HTB = HALF * BK * 2, STAGE_BYTES = 8 * HTB, NXCD = 8, WGM = 8;

__host__ __device__ __forceinline__ int lds_byte(int r, int c) { const int st = (r >> 4) * 2 + (c >> 5), rr = r & 15, cc = c & 31, ob = rr * 64 + cc * 2; return st * 1024 + (ob ^ (((ob >> 9) & 1) << 5)); }
__host__ __device__ __forceinline__ void stage_rc(int b, int& R, int& C) { const int st = b / 1024, sb = b % 1024, swz = sb ^ (((sb >> 9) & 1) << 5); R = (st >> 1) * 16 + swz / 64; C = (st & 1) * 32 + (swz % 64) / 2; }
__host__ __device__ __forceinline__ int perm32(int rho) { const int n = rho >> 4, i = rho & 15; return 8 * (i >> 2) + 4 * n + (i & 3); }

struct Unit { int pm, pn, z; };
struct Gemm { const char* A; int lda; const char* Bt; int K; };

__device__ __forceinline__ unsigned cvt_pk_bf16(float lo, float hi) { unsigned r; asm volatile("v_cvt_pk_bf16_f32 %0, %1, %2" : "=v"(r) : "v"(lo), "v"(hi)); return r; }

struct TileOrder {
    int nM, nN, nwg, G, c;
    __device__ void init(int nM_, int nN_, int G_, int c_) { nM = nM_; nN = nN_; nwg = nM * nN; G = G_; c = c_; }
    __device__ bool tile(int i, int& pm, int& pn) const {
        const long L = (long)i * G + c; if (L >= nwg) return false;
        int wgid = (int)L; { const int q = nwg / NXCD, r = nwg % NXCD, xcd = wgid % NXCD, off = wgid / NXCD; wgid = (xcd < r ? xcd * (q + 1) : r * (q + 1) + (xcd - r) * q) + off; }
        const int nig = WGM * nN, gid = wgid / nig, fm = gid * WGM, gsz = (nM - fm) < WGM ? (nM - fm) : WGM;
        pm = fm + ((wgid % nig) % gsz); pn = (wgid % nig) / gsz; return true;
    }
};

template <class Epi, class Sched>
__device__ __forceinline__ void gemm_phase(PG8_LAS unsigned char* lds, const Gemm g, const Sched& S, const Epi& E) {
    const int tid = threadIdx.x, wid = __builtin_amdgcn_readfirstlane(tid >> 6), lane = tid & 63, wr = wid >> 2, wc = wid & 3, fr = lane & 15, fq = lane >> 4;
    const int K = g.K, nt = K / BK, lda = g.lda;
    unsigned voffA[2], voffB[2];
#pragma unroll
    for (int i = 0; i < 2; ++i) { int R, C; stage_rc(tid * 16 + i * 8192, R, C); const int Rb = Epi::PERM ? ((R & ~31) + perm32(R & 31)) : R;
        voffA[i] = (unsigned)(R * lda + C) * 2u; voffB[i] = (unsigned)(Rb * K + C) * 2u; }
    const size_t kstep = (size_t)(BK * 2);
    const size_t hstepA = (size_t)HALF * lda * 2, hstepB = (size_t)HALF * K * 2;
    const unsigned ldsw = (unsigned)wid * 1024u;
    const int aoff = lds_byte(wr * 64 + fr, fq * 8), boff = lds_byte(wc * 32 + fr, fq * 8);
#define PG8_SA(b, h) (((b) * 2 + (h)) * HTB)
#define PG8_SB(b, h) ((4 + (b) * 2 + (h)) * HTB)
#define PG8_STAGE(bufoff, gbase, voff) do { _Pragma("unroll") for (int _i = 0; _i < 2; ++_i) \
        __builtin_amdgcn_global_load_lds((const unsigned*)((const char*)(gbase) + (voff)[_i]), (PG8_LAS unsigned*)(lds + (bufoff) + ldsw + _i * 8192), 16, 0, 0); } while (0)
#define PG8_LDA(dst, b, h) do { _Pragma("unroll") for (int m = 0; m < 4; ++m) _Pragma("unroll") for (int k = 0; k < 2; ++k) dst[m][k] = *(const PG8_LAS bf16x8*)(lds + PG8_SA(b, h) + aoff + m * 2048 + k * 1024); } while (0)
#define PG8_LDB(dst, b, h) do { _Pragma("unroll") for (int n = 0; n < 2; ++n) _Pragma("unroll") for (int k = 0; k < 2; ++k) dst[n][k] = *(const PG8_LAS bf16x8*)(lds + PG8_SB(b, h) + boff + n * 2048 + k * 1024); } while (0)
#define PG8_MMA(ai, bj, At, Bt) do { __builtin_amdgcn_s_setprio(1); _Pragma("unroll") for (int m = 0; m < 4; ++m) _Pragma("unroll") for (int n = 0; n < 2; ++n) _Pragma("unroll") for (int k = 0; k < 2; ++k) \
        acc[ai][bj][m][n] = __builtin_amdgcn_mfma_f32_16x16x32_bf16(Bt[n][k], At[m][k], acc[ai][bj][m][n], 0, 0, 0); __builtin_amdgcn_s_setprio(0); } while (0)
#define PG8_WAIT_V(n) asm volatile("s_waitcnt vmcnt(" #n ")" ::: "memory")
#define PG8_WAIT_L(n) asm volatile("s_waitcnt lgkmcnt(" #n ")" ::: "memory")
#define PG8_BAR __builtin_amdgcn_s_barrier()
#define PG8_SCHED __builtin_amdgcn_sched_barrier(0)
    Unit cur, nxt; int ui = 0;
    int dbgi = 0;
#define PG8_DBG() do { if constexpr (Epi::DBG) { if (tid == 0 && dbgi < 15) ((volatile PG8_LAS unsigned long long*)(lds + 158 * 1024 + 768))[dbgi] = __builtin_amdgcn_s_memrealtime(); ++dbgi; } } while (0)
    PG8_DBG();
    if (!S.next(0, cur)) return;
    f32x4 acc[2][2][4][2];
#pragma unroll
    for (int a = 0; a < 2; ++a)
#pragma unroll
        for (int b = 0; b < 2; ++b)
#pragma unroll
            for (int m = 0; m < 4; ++m)
#pragma unroll
                for (int n = 0; n < 2; ++n) acc[a][b][m][n] = (f32x4){0.f, 0.f, 0.f, 0.f};
    bf16x8 At[4][2], B0[2][2], B1[2][2];
    const char* cA = g.A + S.a_off(cur); const char* cB = g.Bt + S.b_off(cur);
    {
        PG8_STAGE(PG8_SB(0, 0), cB, voffB); PG8_STAGE(PG8_SB(0, 1), cB + hstepB, voffB); PG8_STAGE(PG8_SA(0, 0), cA, voffA); PG8_STAGE(PG8_SA(0, 1), cA + hstepA, voffA);
        if (wr == 1) PG8_BAR;
        PG8_WAIT_V(2); PG8_BAR;
        PG8_STAGE(PG8_SB(1, 0), cB + kstep, voffB); PG8_STAGE(PG8_SA(1, 0), cA + kstep, voffA); PG8_STAGE(PG8_SB(1, 1), cB + hstepB + kstep, voffB);
        PG8_WAIT_V(6); PG8_BAR;
    }
    for (;;) {
        const bool has_next = S.next(ui + 1, nxt);
        const char* nA = has_next ? g.A + S.a_off(nxt) : cA; const char* nB = has_next ? g.Bt + S.b_off(nxt) : cB;
        for (int t = 0; t < nt; t += 2) {
            const bool last = (t == nt - 2);
            const char* a1 = cA + (size_t)(t + 1) * kstep;
            const char* a2 = last ? nA : cA + (size_t)(t + 2) * kstep; const char* b2 = last ? nB : cB + (size_t)(t + 2) * kstep;
            const char* a3 = a2 + kstep; const char* b3 = b2 + kstep;
            PG8_LDB(B0, 0, 0); PG8_LDB(B1, 0, 1); PG8_SCHED; PG8_LDA(At, 0, 0); PG8_STAGE(PG8_SA(1, 1), a1 + hstepA, voffA);
            PG8_WAIT_V(8); PG8_WAIT_L(0); PG8_BAR; PG8_MMA(0, 0, At, B0); PG8_MMA(0, 1, At, B1); PG8_BAR; PG8_SCHED;
            PG8_LDA(At, 0, 1); PG8_STAGE(PG8_SB(0, 0), b2, voffB); PG8_STAGE(PG8_SB(0, 1), b2 + hstepB, voffB); PG8_STAGE(PG8_SA(0, 0), a2, voffA);
            PG8_WAIT_V(8); PG8_WAIT_L(0); PG8_BAR; PG8_MMA(1, 0, At, B0); PG8_MMA(1, 1, At, B1); PG8_BAR; PG8_SCHED;
            PG8_LDB(B0, 1, 0); PG8_LDB(B1, 1, 1); PG8_SCHED; PG8_LDA(At, 1, 0); PG8_STAGE(PG8_SA(0, 1), a2 + hstepA, voffA);
            PG8_WAIT_V(8); PG8_WAIT_L(0); PG8_BAR; PG8_MMA(0, 0, At, B0); PG8_MMA(0, 1, At, B1); PG8_BAR; PG8_SCHED;
            PG8_LDA(At, 1, 1); PG8_STAGE(PG8_SB(1, 0), b3, voffB); PG8_STAGE(PG8_SB(1, 1), b3 + hstepB, voffB); PG8_STAGE(PG8_SA(1, 0), a3, voffA);
            PG8_WAIT_V(8); PG8_WAIT_L(0); PG8_BAR; PG8_MMA(1, 0, At, B0); PG8_MMA(1, 1, At, B1); PG8_BAR; PG8_SCHED;
        }
        if (wr == 0) PG8_BAR;
        PG8_DBG();
        const bool rst = E(acc, cur, wr, wc, fr, fq);
        PG8_DBG();
        if (!has_next) break;
        if (rst) {
#pragma unroll
        for (int a = 0; a < 2; ++a)
#pragma unroll
            for (int b = 0; b < 2; ++b)
#pragma unroll
                for (int m = 0; m < 4; ++m)
#pragma unroll
                    for (int n = 0; n < 2; ++n) acc[a][b][m][n] = (f32x4){0.f, 0.f, 0.f, 0.f};
        }
        cur = nxt; cA = nA; cB = nB; ++ui;
        if (wr == 1) PG8_BAR;
    }
    PG8_WAIT_V(0);
    PG8_BAR;
#undef PG8_SA
#undef PG8_SB
#undef PG8_STAGE
#undef PG8_LDA
#undef PG8_LDB
#undef PG8_MMA
#undef PG8_WAIT_V
#undef PG8_WAIT_L
#undef PG8_BAR
#undef PG8_SCHED
}
}

constexpr int NWAVES = 8, NTHR = 512;
constexpr int N_LAUNCHES = MK_N_LAUNCHES;
constexpr int N_PHASES = 15;
constexpr int DM = 1024, BATCH = 8, SEQ = 2048, DECB = 128, DECS = 8, NMETA = 16;
constexpr int PT = SEQ + NMETA;
constexpr int ROW0 = 48;
constexpr int PROWS = BATCH * PT;
constexpr int SROW0 = ROW0 + PROWS;
constexpr int SROWS = DECB * DECS;
constexpr int RTOK = SROW0 + SROWS;
constexpr int R = 17664;
constexpr int NCH = 33;
constexpr int NIN = 12312, NBIG = 12288;
constexpr int LDU = NBIG + 64;
constexpr int C_Q = 0, C_K = 512, C_V = 1024, C_O = 2048, C_Z = 3072, C_LX = 4096, C_LZ = 5120, C_SZ = 6144, C_XBC = 7168, C_G = 9216;
constexpr int C_TMP = 2048;
constexpr int USMW = 32;
constexpr float EPS = 1e-6f;

constexpr size_t MiB = 1u << 20;
constexpr size_t WS_CTL = 0, CTL_ZERO_BYTES = 1 * MiB;
constexpr size_t WS_U = 1 * MiB;
constexpr size_t WS_USM = WS_U + (size_t)R * LDU * 2;
constexpr size_t WS_XN = WS_USM + (size_t)R * USMW * 4;
constexpr size_t WS_WIN = WS_XN + (size_t)R * DM * 2;
constexpr size_t WS_WBR = WS_WIN + (size_t)NBIG * DM * 2;
constexpr size_t WS_WOUT = WS_WBR + (size_t)6 * DM * DM * 2;
constexpr size_t WS_WLRU = WS_WOUT + (size_t)2 * DM * DM * 2;
constexpr size_t WS_XAUX = WS_WLRU + (size_t)2 * 2 * 16 * 64 * 64 * 2;
constexpr size_t WS_END = WS_XAUX + (size_t)256 * DM * 4;
static_assert(WS_END <= 512 * MiB, "d_ws map must fit 512 MiB");
static_assert(WS_USM % 256 == 0 && WS_XN % 256 == 0 && WS_WIN % 256 == 0 && WS_WBR % 256 == 0 && WS_WLRU % 256 == 0 && WS_XAUX % 256 == 0, "alignment");
constexpr int CW_TMO = 0, CW_CODE = 1, CW_BAR = 4096;
constexpr size_t O_YP = 0, O_YS = O_YP + (size_t)BATCH * SEQ * DM, O_PC = O_YS + (size_t)SROWS * DM, O_PN = O_PC + (size_t)2 * 8 * 4 * 128 * 256,
    O_PM = O_PN + 2 * 8 * 4 * 128, O_PHL = O_PM + 2 * 8 * 4, O_PCL = O_PHL + 2 * 8 * 1024, O_PHS = O_PCL + 2 * 8 * 3 * 1024, O_PCS = O_PHS + (size_t)2 * 8 * 16 * 64 * 128,
    O_SC = O_PCS + 2 * 8 * 3 * 2048, O_SN = O_SC + (size_t)2 * 128 * 4 * 128 * 256, O_SM = O_SN + 2 * 128 * 4 * 128, O_SHL = O_SM + 2 * 128 * 4, O_SCL = O_SHL + 2 * 128 * 1024,
    O_SHS = O_SCL + 2 * 128 * 3 * 1024, O_SCS = O_SHS + (size_t)2 * 128 * 16 * 64 * 128, O_END = O_SCS + 2 * 128 * 3 * 2048;

constexpr int RING_BYTES = 131072;
constexpr int LDSCTL_OFF = 158 * 1024, MISC_OFF = LDSCTL_OFF + 320;
constexpr int LDS_BYTES = 160 * 1024;
static_assert(MISC_OFF + 128 <= LDS_BYTES && LDSCTL_OFF + 1024 + 16 * 8 <= LDS_BYTES, "LDS map");

#define GAS __attribute__((address_space(1)))
#define LAS __attribute__((address_space(3)))
typedef unsigned short bf16;
typedef unsigned v4u __attribute__((ext_vector_type(4)));
typedef unsigned v2u __attribute__((ext_vector_type(2)));
typedef float f32x4 __attribute__((ext_vector_type(4)));
typedef float f32x2 __attribute__((ext_vector_type(2)));
typedef short bf16x8 __attribute__((ext_vector_type(8)));
typedef GAS unsigned gu32;
#define RLX_AGENT __ATOMIC_RELAXED, __HIP_MEMORY_SCOPE_AGENT
#define LDS_WAIT() asm volatile("s_waitcnt lgkmcnt(0)" ::: "memory")
#define VM_WAIT() asm volatile("s_waitcnt vmcnt(0)" ::: "memory")
#define LBAR() do { asm volatile("s_waitcnt lgkmcnt(0)" ::: "memory"); __builtin_amdgcn_s_barrier(); asm volatile("" ::: "memory"); } while (0)
__device__ __forceinline__ unsigned f2bf(float f) { unsigned u = __builtin_bit_cast(unsigned, f); return (u + 0x7fffu + ((u >> 16) & 1u)) >> 16; }
__device__ __forceinline__ unsigned pk2(float lo, float hi) { return f2bf(lo) | (f2bf(hi) << 16); }
__device__ __forceinline__ float bf2f(unsigned short b) { return __builtin_bit_cast(float, (unsigned)b << 16); }
__device__ __forceinline__ float bflo(unsigned w) { return __builtin_bit_cast(float, w << 16); }
__device__ __forceinline__ float bfhi(unsigned w) { return __builtin_bit_cast(float, w & 0xffff0000u); }
__device__ __forceinline__ float sigmoidf_(float x) { return 1.f / (1.f + __expf(-x)); }
__device__ __forceinline__ float siluf_(float x) { return x / (1.f + __expf(-x)); }
__device__ __forceinline__ float softplusf_(float x) { return fmaxf(x, 0.f) + log1pf(__expf(-fabsf(x))); }
__device__ __forceinline__ float logsigmoidf_(float x) { return fminf(x, 0.f) - log1pf(__expf(-fabsf(x))); }
__device__ __forceinline__ float wave_sum(float v) {
#pragma unroll
    for (int o = 1; o < 64; o <<= 1) v += __shfl_xor(v, o);
    return v;
}

#define XB_TMO      128
#define XB_XCNT(j)  (256  + 64 * (j))
#define XB_XSUB(j)  (1280 + 64 * (j))
#define XB_XGEN(j)  (2304 + 64 * (j))
#define XB_TOP      3328
#define XB_TOPGEN   3392
#define XCD_BAR_WORDS 3456
#define XB_SPIN_CAP (1u << 22)
__device__ __forceinline__ unsigned xb_ld(unsigned* p)              { return __hip_atomic_load(p, __ATOMIC_RELAXED, __HIP_MEMORY_SCOPE_AGENT); }
__device__ __forceinline__ unsigned xb_add(unsigned* p, unsigned v) { return __hip_atomic_fetch_add(p, v, __ATOMIC_RELAXED, __HIP_MEMORY_SCOPE_AGENT); }
__device__ __forceinline__ unsigned xb_xcc_id() { return (unsigned)__builtin_amdgcn_s_getreg((3 << 11) | 20) & 0xFu; }
#define XB_SPIN(cond, bar) do { unsigned _sp = 0; while (cond) { __builtin_amdgcn_s_sleep(1); \
    if ((++_sp & 255u) == 0u) { if (xb_ld(&(bar)[XB_TMO])) break; if (_sp > XB_SPIN_CAP) { atomicAdd(&(bar)[XB_TMO], 1u); break; } } } } while (0)
struct XcdBarrier { unsigned* bar; unsigned x; volatile LAS unsigned* st; };
__device__ __forceinline__ XcdBarrier xcd_barrier_post(unsigned* bar, volatile LAS unsigned* st) {
    XcdBarrier b; b.bar = bar; b.x = xb_xcc_id(); b.st = st;
    if (threadIdx.x == 0) (void)xb_add(&bar[XB_XCNT(b.x)], 1u);
    return b;
}
__device__ __forceinline__ void xcd_barrier_complete(unsigned* bar, unsigned x, unsigned& nloc, unsigned& nx) {
    const unsigned G = gridDim.x * gridDim.y * gridDim.z;
    unsigned sum, cnt, mine, sp = 0u;
    for (;;) {
        sum = 0u; cnt = 0u; mine = 0u;
#pragma unroll
        for (unsigned j = 0; j < 16; ++j) { const unsigned c = xb_ld(&bar[XB_XCNT(j)]); sum += c; cnt += (c > 0u) ? 1u : 0u; mine = (j == x) ? c : mine; }
        if (sum == G) break;
        __builtin_amdgcn_s_sleep(1);
        if ((++sp & 255u) == 0u) { if (xb_ld(&bar[XB_TMO])) break; if (sp > XB_SPIN_CAP) { atomicAdd(&bar[XB_TMO], 1u); break; } }
    }
    nloc = mine > 0u ? mine : 1u; nx = cnt > 0u ? cnt : 1u;
}
__device__ __forceinline__ void xcd_barrier(const XcdBarrier& b) {
    asm volatile("s_waitcnt vmcnt(0)" ::: "memory");
    __syncthreads();
    if (threadIdx.x == 0) {
        unsigned* bar = b.bar;
        __builtin_amdgcn_s_waitcnt(0);
        unsigned nloc = b.st[0], nx = b.st[1];
        if (nloc == 0u) { xcd_barrier_complete(bar, b.x, nloc, nx); b.st[0] = nloc; b.st[1] = nx; }
        const unsigned old = xb_add(&bar[XB_XSUB(b.x)], 1u);
        const unsigned gen = old / nloc;
        if (old + 1u == (gen + 1u) * nloc) {
            __builtin_amdgcn_fence(__ATOMIC_RELEASE, "agent");
            asm volatile("s_waitcnt vmcnt(0)" ::: "memory");
            const unsigned og = xb_add(&bar[XB_TOP], 1u);
            const unsigned tg = og / nx;
            if (og + 1u == (tg + 1u) * nx) xb_add(&bar[XB_TOPGEN], 1u);
            else XB_SPIN(xb_ld(&bar[XB_TOPGEN]) == tg, bar);
            __builtin_amdgcn_fence(__ATOMIC_ACQUIRE, "agent");
            xb_add(&bar[XB_XGEN(b.x)], 1u);
            asm volatile("s_waitcnt vmcnt(0)" ::: "memory");
        } else {
            XB_SPIN(xb_ld(&bar[XB_XGEN(b.x)]) == gen, bar);
            __builtin_amdgcn_fence(__ATOMIC_ACQUIRE, "agent");
            asm volatile("s_waitcnt vmcnt(0)" ::: "memory");
        }
    }
    __syncthreads();
}

struct Args { const float* in[32]; float* out; unsigned char* ws; int ph_lo, ph_hi, li, pad; };
struct Frame {
    LAS unsigned char* lds;
    volatile LAS unsigned* MISC;
    gu32* ctl;
    int tid, lane, wave, vcu, G;
    float* out; unsigned char* ws;
    bf16 *U, *XN, *WIN, *WBR, *WOUT, *WLRU; float *USM, *XAUX;
};
enum { I_XP = 0, I_XS, I_SC, I_SN, I_SM, I_SHL, I_SCL, I_SHS, I_SCS, I_META, I_WIN, I_NORMG, I_FBIAS, I_MLNG, I_LCW, I_LCB, I_LWA, I_LBA, I_LWX, I_LBX, I_LLAM,
       I_SCW, I_SCB, I_SDTB, I_SALOG, I_SD, I_SNG, I_WBML, I_WBLRU, I_WBSSD, I_WOUT, I_FNG };

constexpr int PTR_OFF = LDSCTL_OFF + 512;
__device__ __forceinline__ const float* inp(const Frame& F, int i) {
    const volatile LAS unsigned* t = (const volatile LAS unsigned*)(F.lds + PTR_OFF) + 2 * i;
    const unsigned lo = __builtin_amdgcn_readfirstlane(t[0]), hi = __builtin_amdgcn_readfirstlane(t[1]);
    return (const float*)(((unsigned long long)hi << 32) | lo);
}
__device__ __forceinline__ const float* x0_row(const Frame& a, int row) {
    if (row < ROW0 || row >= RTOK) return nullptr;
    if (row >= SROW0) return inp(a, I_XS) + (size_t)(row - SROW0) * DM;
    const int p = row - ROW0, b = p / PT, t = p - b * PT;
    if (t < NMETA) return inp(a, I_META) + (size_t)t * DM;
    return inp(a, I_XP) + ((size_t)b * SEQ + (t - NMETA)) * DM;
}
__device__ __forceinline__ float* x1_row(float* out, float* xaux, int row) {
    if (row < ROW0) return xaux + (size_t)row * DM;
    if (row >= RTOK) return xaux + (size_t)(176 + row - RTOK) * DM;
    if (row >= SROW0) return out + O_YS + (size_t)(row - SROW0) * DM;
    const int p = row - ROW0, b = p / PT, t = p - b * PT;
    if (t < NMETA) return xaux + (size_t)(48 + b * NMETA + t) * DM;
    return out + O_YP + ((size_t)b * SEQ + (t - NMETA)) * DM;
}

__device__ __forceinline__ void transpose_item(const float* W, int ldw, int K, bf16* WT, int k0, int csrc0, int orow0, float scale, LAS float* scr, int lane) {
#pragma unroll 8
    for (int i = 0; i < 32; ++i) { const int kk = 2 * i + (lane >> 5); scr[kk * 33 + (lane & 31)] = W[(size_t)(k0 + kk) * ldw + csrc0 + (lane & 31)]; }
    LDS_WAIT(); asm volatile("" ::: "memory");
    const int c = lane & 7;
#pragma unroll
    for (int j = 0; j < 4; ++j) { const int n = (lane >> 3) + 8 * j; const LAS float* s = scr + (8 * c) * 33 + n;
        v4u o; o.x = pk2(s[0 * 33] * scale, s[1 * 33] * scale); o.y = pk2(s[2 * 33] * scale, s[3 * 33] * scale); o.z = pk2(s[4 * 33] * scale, s[5 * 33] * scale); o.w = pk2(s[6 * 33] * scale, s[7 * 33] * scale);
        *(GAS v4u*)(WT + (size_t)(orow0 + n) * K + k0 + 8 * c) = o; }
    LDS_WAIT(); asm volatile("" ::: "memory");
}
__device__ __forceinline__ void win_item(Frame& F, int layer, int it, LAS float* scr) {
    const int kb = it / 384, nb = it % 384, n0 = nb * 32;
    const int csrc = n0 + (n0 >= 2048 ? 8 : 0) + (n0 >= 9216 ? 16 : 0);
    const float scale = (n0 >= C_K && n0 < C_V) ? 0.08838834764831845f : 1.0f;
    transpose_item(inp(F, I_WIN) + (size_t)layer * DM * NIN, NIN, DM, F.WIN, kb * 64, csrc, n0, scale, scr, F.lane);
}
constexpr int WIN_ITEMS = 16 * 384;
constexpr int WSQ_ITEMS = 2 * 4 * 512, WLRU_ITEMS = 2 * 2 * 16 * 2;
__device__ __forceinline__ void wsq_item(Frame& F, int it, LAS float* scr) {
    const int layer = it / 2048, r = it % 2048, m = r / 512, q = r % 512, kb = q / 32, nb = q % 32;
    const float* W = inp(F, m == 0 ? I_WBML : m == 1 ? I_WBLRU : m == 2 ? I_WBSSD : I_WOUT) + (size_t)layer * DM * DM;
    bf16* WT = (m < 3) ? F.WBR + ((size_t)layer * 3 + m) * DM * DM : F.WOUT + (size_t)layer * DM * DM;
    transpose_item(W, DM, DM, WT, kb * 64, nb * 32, nb * 32, 1.0f, scr, F.lane);
}
__device__ __forceinline__ void wlru_item(Frame& F, int it, LAS float* scr) {
    const int nb = it & 1, blk = (it >> 1) & 15, ax = (it >> 5) & 1, layer = it >> 6;
    const float* W = inp(F, ax ? I_LWX : I_LWA) + ((size_t)layer * 16 + blk) * 64 * 64;
    bf16* WT = F.WLRU + (((size_t)layer * 2 + ax) * 16 + blk) * 64 * 64;
    transpose_item(W, 64, 64, WT, 0, nb * 32, nb * 32, 1.0f, scr, F.lane);
}
constexpr int WSM_LD = 1028;
__device__ __forceinline__ void norm_rows(Frame& F, int layer) {
    LAS float* Wsm = (LAS float*)F.lds;
    const float* W = inp(F, I_WIN) + (size_t)layer * DM * NIN;
    for (int idx = F.tid; idx < 24 * DM; idx += NTHR) { const int k = idx / 24, c = idx - k * 24; const int col = (c < 8) ? 2048 + c : 9224 + (c - 8);
        Wsm[c * WSM_LD + k] = W[(size_t)k * NIN + col]; }
    __syncthreads();
    const float* g = inp(F, I_NORMG) + layer * DM;
    f32x4 gv[4];
#pragma unroll
    for (int j = 0; j < 4; ++j) gv[j] = *(const f32x4*)(g + 4 * F.lane + 256 * j);
    const int gw = F.vcu * NWAVES + F.wave, NGW = F.G * NWAVES;
    const bool b5 = (F.lane & 32) != 0, b4 = (F.lane & 16) != 0, b3 = (F.lane & 8) != 0;
    f32x4 vn[4]; bool realn = false;
    { const int row = gw; const float* xr = (row < R) ? ((layer == 0) ? x0_row(F, row) : (const float*)x1_row(F.out, F.XAUX, row)) : nullptr;
      realn = (xr != nullptr) && row >= ROW0 && row < RTOK;
      if (realn) {
#pragma unroll
          for (int j = 0; j < 4; ++j) vn[j] = *(const f32x4*)(xr + 4 * F.lane + 256 * j); } }
    for (int row = gw; row < R; row += NGW) {
        f32x4 v[4]; const bool real = realn;
#pragma unroll
        for (int j = 0; j < 4; ++j) v[j] = vn[j];
        { const int rn = row + NGW; const float* xr = (rn < R) ? ((layer == 0) ? x0_row(F, rn) : (const float*)x1_row(F.out, F.XAUX, rn)) : nullptr;
          realn = (xr != nullptr) && rn >= ROW0 && rn < RTOK;
          if (realn) {
#pragma unroll
              for (int j = 0; j < 4; ++j) vn[j] = *(const f32x4*)(xr + 4 * F.lane + 256 * j); } }
        GAS unsigned long long* o8 = (GAS unsigned long long*)(F.XN + (size_t)row * DM) + F.lane;
        float* us = F.USM + (size_t)row * USMW;
        if (!real) {
#pragma unroll
            for (int j = 0; j < 4; ++j) o8[64 * j] = 0ull;
            if (F.lane < USMW) us[F.lane] = 0.f;
            continue;
        }
        float s = 0.f;
#pragma unroll
        for (int j = 0; j < 4; ++j) s += (v[j].x * v[j].x + v[j].y * v[j].y) + (v[j].z * v[j].z + v[j].w * v[j].w);
        const float rstd = 1.0f / sqrtf(wave_sum(s) * (1.f / DM) + EPS);
#pragma unroll
        for (int j = 0; j < 4; ++j) { v[j] = v[j] * rstd * gv[j];
            o8[64 * j] = (unsigned long long)pk2(v[j].x, v[j].y) | ((unsigned long long)pk2(v[j].z, v[j].w) << 32); }
#pragma unroll
        for (int g8 = 0; g8 < 3; ++g8) {
            float d[8];
#pragma unroll
            for (int c = 0; c < 8; ++c) { float a = 0.f;
#pragma unroll
                for (int j = 0; j < 4; ++j) { const f32x4 w = *(const LAS f32x4*)(Wsm + (g8 * 8 + c) * WSM_LD + 4 * F.lane + 256 * j); a += (v[j].x * w.x + v[j].y * w.y) + (v[j].z * w.z + v[j].w * w.w); }
                d[c] = a; }
            float w4[4], x2[2];
#pragma unroll
            for (int i = 0; i < 4; ++i) { const float send = b5 ? d[i] : d[4 + i], keep = b5 ? d[4 + i] : d[i]; w4[i] = keep + __shfl_xor(send, 32); }
#pragma unroll
            for (int i = 0; i < 2; ++i) { const float send = b4 ? w4[i] : w4[2 + i], keep = b4 ? w4[2 + i] : w4[i]; x2[i] = keep + __shfl_xor(send, 16); }
            float y; { const float send = b3 ? x2[0] : x2[1], keep = b3 ? x2[1] : x2[0]; y = keep + __shfl_xor(send, 8); }
            y += __shfl_xor(y, 4); y += __shfl_xor(y, 2); y += __shfl_xor(y, 1);
            if ((F.lane & 7) == 0) us[g8 * 8 + (F.lane >> 3)] = y;
        }
        if (F.lane < 8) us[24 + F.lane] = 0.f;
    }
}
__device__ __forceinline__ void unpack16(const v4u a, const v4u b, float (&o)[16]) {
    o[0] = bflo(a.x); o[1] = bfhi(a.x); o[2] = bflo(a.y); o[3] = bfhi(a.y); o[4] = bflo(a.z); o[5] = bfhi(a.z); o[6] = bflo(a.w); o[7] = bfhi(a.w);
    o[8] = bflo(b.x); o[9] = bfhi(b.x); o[10] = bflo(b.y); o[11] = bfhi(b.y); o[12] = bflo(b.z); o[13] = bfhi(b.z); o[14] = bflo(b.w); o[15] = bfhi(b.w);
}

struct SchedIn {
    pg8::TileOrder T;
    __device__ __forceinline__ bool next(int i, pg8::Unit& u) const { u.z = 0; return T.tile(i, u.pm, u.pn); }
    __device__ __forceinline__ size_t a_off(const pg8::Unit& u) const { return (size_t)u.pm * 256 * DM * 2; }
    __device__ __forceinline__ size_t b_off(const pg8::Unit& u) const { return (size_t)u.pn * 256 * DM * 2; }
};
struct EpiU {
    static constexpr bool PERM = true, DBG = false;
    bf16* U;
    __device__ __forceinline__ bool operator()(f32x4 (&acc)[2][2][4][2], const pg8::Unit& u, int wr, int wc, int fr, int fq) const {
        const int row0 = u.pm * 256 + wr * 64 + fr;
        if (u.pn * 256 >= C_G) {
            const int col0 = u.pn * 256 + (wc * 4 + fq) * 16;
#pragma unroll
            for (int ai = 0; ai < 2; ++ai)
#pragma unroll
                for (int m = 0; m < 4; ++m) { bf16* rowp = U + (size_t)(row0 + ai * 128 + m * 16) * LDU + col0;
#pragma unroll
                    for (int bj = 0; bj < 2; ++bj) { const f32x4 v0 = acc[ai][bj][m][0], v1 = acc[ai][bj][m][1];
                        v4u w; w.x = pg8::cvt_pk_bf16(sigmoidf_(v0[0]), sigmoidf_(v0[1])); w.y = pg8::cvt_pk_bf16(sigmoidf_(v0[2]), sigmoidf_(v0[3]));
                        w.z = pg8::cvt_pk_bf16(sigmoidf_(v1[0]), sigmoidf_(v1[1])); w.w = pg8::cvt_pk_bf16(sigmoidf_(v1[2]), sigmoidf_(v1[3]));
                        *(v4u*)(rowp + bj * 8) = w; } }
            return true;
        }
        const int col0 = u.pn * 256 + wc * 32 + 8 * fq;
#pragma unroll
        for (int ai = 0; ai < 2; ++ai)
#pragma unroll
            for (int m = 0; m < 4; ++m) { bf16* rowp = U + (size_t)(row0 + ai * 128 + m * 16) * LDU + col0;
#pragma unroll
                for (int bj = 0; bj < 2; ++bj) { const f32x4 v0 = acc[ai][bj][m][0], v1 = acc[ai][bj][m][1];
                    v4u w; w.x = pg8::cvt_pk_bf16(v0[0], v0[1]); w.y = pg8::cvt_pk_bf16(v0[2], v0[3]); w.z = pg8::cvt_pk_bf16(v1[0], v1[1]); w.w = pg8::cvt_pk_bf16(v1[2], v1[3]);
                    *(v4u*)(rowp + bj * 128) = w; } }
        return true;
    }
};
struct SchedBr {
    pg8::TileOrder T; int layer;
    __device__ __forceinline__ bool next(int i, pg8::Unit& u) const { u.z = i % 3; return T.tile(i / 3, u.pm, u.pn); }
    __device__ __forceinline__ size_t a_off(const pg8::Unit& u) const { const int col = (u.z == 0) ? C_V : (u.z == 1) ? C_LZ : C_SZ; return ((size_t)u.pm * 256 * LDU + col) * 2; }
    __device__ __forceinline__ size_t b_off(const pg8::Unit& u) const { return ((size_t)(layer * 3 + u.z) * DM * DM + (size_t)u.pn * 256 * DM) * 2; }
};
struct EpiBr {
    static constexpr bool PERM = true;
#if defined(DBG_TIMING) && DBG_TIMING == 3
    static constexpr bool DBG = true;
#else
    static constexpr bool DBG = false;
#endif
    bf16* U; bf16* MG;
    __device__ __forceinline__ bool operator()(f32x4 (&acc)[2][2][4][2], const pg8::Unit& u, int wr, int wc, int fr, int fq) const {
        const int row0 = u.pm * 256 + wr * 64 + fr, gcol = C_G + u.pn * 256 + (wc * 4 + fq) * 16, col0 = u.pn * 256 + wc * 32 + 8 * fq;
#pragma unroll
        for (int ai = 0; ai < 2; ++ai)
#pragma unroll
            for (int m = 0; m < 4; ++m) { const int row = row0 + ai * 128 + m * 16; const bf16* ur = U + (size_t)row * LDU + gcol;
                const v4u ga0 = *(const v4u*)(ur + u.z * DM), ga1 = *(const v4u*)(ur + u.z * DM + 8);
                float a[16]; unpack16(ga0, ga1, a);
                if (u.z < 2) { const v4u gb0 = *(const v4u*)(ur + (u.z + 1) * DM), gb1 = *(const v4u*)(ur + (u.z + 1) * DM + 8);
                    float b[16]; unpack16(gb0, gb1, b);
#pragma unroll
                    for (int bj = 0; bj < 2; ++bj)
#pragma unroll
                        for (int n = 0; n < 2; ++n)
#pragma unroll
                            for (int e = 0; e < 4; ++e) acc[ai][bj][m][n][e] *= a[bj * 8 + n * 4 + e] * __builtin_amdgcn_rcpf(fmaxf(b[bj * 8 + n * 4 + e], 1e-30f));
                } else {
#pragma unroll
                    for (int bj = 0; bj < 2; ++bj) { f32x4 v0 = acc[ai][bj][m][0], v1 = acc[ai][bj][m][1];
#pragma unroll
                        for (int e = 0; e < 4; ++e) { v0[e] *= a[bj * 8 + e]; v1[e] *= a[bj * 8 + 4 + e]; }
                        v4u w; w.x = pg8::cvt_pk_bf16(v0[0], v0[1]); w.y = pg8::cvt_pk_bf16(v0[2], v0[3]); w.z = pg8::cvt_pk_bf16(v1[0], v1[1]); w.w = pg8::cvt_pk_bf16(v1[2], v1[3]);
                        *(v4u*)(MG + (size_t)row * DM + col0 + bj * 128) = w; }
                } }
        return u.z == 2;
    }
};
struct SchedOut {
    pg8::TileOrder T; int layer;
    __device__ __forceinline__ bool next(int i, pg8::Unit& u) const { u.z = 0; return T.tile(i, u.pm, u.pn); }
    __device__ __forceinline__ size_t a_off(const pg8::Unit& u) const { return (size_t)u.pm * 256 * DM * 2; }
    __device__ __forceinline__ size_t b_off(const pg8::Unit& u) const { return ((size_t)layer * DM * DM + (size_t)u.pn * 256 * DM) * 2; }
};
struct EpiOut {
    static constexpr bool PERM = false, DBG = false;
    const Frame* a; float* out; float* xaux; int layer;
    __device__ __forceinline__ bool operator()(f32x4 (&acc)[2][2][4][2], const pg8::Unit& u, int wr, int wc, int fr, int fq) const {
        const int row0 = u.pm * 256 + wr * 64 + fr, col0 = u.pn * 256 + wc * 32 + 4 * fq;
#pragma unroll
        for (int ai = 0; ai < 2; ++ai)
#pragma unroll
            for (int m = 0; m < 4; ++m) { const int row = row0 + ai * 128 + m * 16;
                float* dst = x1_row(out, xaux, row); const float* src = (layer == 0) ? x0_row(*a, row) : (const float*)dst;
#pragma unroll
                for (int bj = 0; bj < 2; ++bj)
#pragma unroll
                    for (int n = 0; n < 2; ++n) { const int col = col0 + bj * 128 + n * 16;
                        f32x4 v = acc[ai][bj][m][n]; if (src) v = v + *(const f32x4*)(src + col);
                        *(f32x4*)(dst + col) = v; } }
        return true;
    }
};

__device__ __forceinline__ void conv_state_out(Frame& F, int layer) {
    const int gt = F.vcu * NTHR + F.tid, NG = F.G * NTHR;
    for (int i = gt; i < BATCH * 3 * 1024; i += NG) { const int ch = i & 1023, j = (i >> 10) % 3, b = i / 3072; const int row = ROW0 + b * PT + (PT - 3) + j;
        F.out[O_PCL + ((size_t)(layer * BATCH + b) * 3 + j) * 1024 + ch] = bf2f(F.U[(size_t)row * LDU + C_LX + ch]); }
    for (int i = gt; i < BATCH * 3 * 2048; i += NG) { const int ch = i & 2047, j = (i >> 11) % 3, b = i / 6144; const int row = ROW0 + b * PT + (PT - 3) + j;
        F.out[O_PCS + ((size_t)(layer * BATCH + b) * 3 + j) * 2048 + ch] = bf2f(F.U[(size_t)row * LDU + C_XBC + ch]); }
    for (int i = gt; i < DECB * 3 * 1024; i += NG) { const int ch = i & 1023, j = (i >> 10) % 3, b = i / 3072; const int row = SROW0 + b * DECS + (DECS - 3) + j;
        F.out[O_SCL + ((size_t)(layer * DECB + b) * 3 + j) * 1024 + ch] = bf2f(F.U[(size_t)row * LDU + C_LX + ch]); }
    for (int i = gt; i < DECB * 3 * 2048; i += NG) { const int ch = i & 2047, j = (i >> 11) % 3, b = i / 6144; const int row = SROW0 + b * DECS + (DECS - 3) + j;
        F.out[O_SCS + ((size_t)(layer * DECB + b) * 3 + j) * 2048 + ch] = bf2f(F.U[(size_t)row * LDU + C_XBC + ch]); }
}

#define MFMA16(a, b, c) __builtin_amdgcn_mfma_f32_16x16x32_bf16(a, b, c, 0, 0, 0)
__device__ __forceinline__ bf16x8 ldfrag(const LAS unsigned char* base, int ld, int row, int k) { return *(const LAS bf16x8*)(base + (row * ld + k) * 2); }
__device__ __forceinline__ float scan_add(float x, int lane) {
#pragma unroll
    for (int o = 1; o < 64; o <<= 1) { const float t = __shfl_up(x, o); if (lane >= o) x += t; }
    return x;
}
__device__ __forceinline__ float scan_max(float x, int lane) {
#pragma unroll
    for (int o = 1; o < 64; o <<= 1) { const float t = __shfl_up(x, o); if (lane >= o) x = fmaxf(x, t); }
    return x;
}
constexpr int L_QS = 0, L_KS = 17408, L_KT = 34816, L_PS = 53248, L_V2 = 71680, L_VT = 90112, L_CT = 108544, L_FA = 143360, L_CW = 147456, L_TAIL = 155136;
constexpr int L_RAW = L_KT, RAWLD = 128;
constexpr int LDQ = 136, LDT = 72, NV = 128;
constexpr int FA_COLV = 0, FA_ROWV = 64, FA_INTER = 128, FA_KS = 192, FA_CLAMP = 256, FA_HSTR = 320, FA_DENS = 640, FA_QN = 704, FA_NVEC = 768, FA_SC = 896;
static_assert(L_TAIL + 3 * 128 * 2 <= LDSCTL_OFF && 67 * RAWLD * 2 <= L_PS - L_KT, "scan LDS map");

#define dpp_f(ident, v, ctrl, row_mask) __builtin_bit_cast(float, __builtin_amdgcn_update_dpp(__builtin_bit_cast(int, (float)(ident)), __builtin_bit_cast(int, (float)(v)), (ctrl), (row_mask), 0xf, false))
__device__ __forceinline__ float wave_cumsum(float v) {
    v += dpp_f(0.f, v, 0x111, 0xf); v += dpp_f(0.f, v, 0x112, 0xf); v += dpp_f(0.f, v, 0x114, 0xf); v += dpp_f(0.f, v, 0x118, 0xf);
    v += dpp_f(0.f, v, 0x142, 0xa);
    v += dpp_f(0.f, v, 0x143, 0xc);
    return v;
}
__device__ __forceinline__ float wave_cummax(float v) {
    const float ni = -INFINITY;
    v = fmaxf(v, dpp_f(ni, v, 0x111, 0xf)); v = fmaxf(v, dpp_f(ni, v, 0x112, 0xf)); v = fmaxf(v, dpp_f(ni, v, 0x114, 0xf)); v = fmaxf(v, dpp_f(ni, v, 0x118, 0xf));
    v = fmaxf(v, dpp_f(ni, v, 0x142, 0xa));
    v = fmaxf(v, dpp_f(ni, v, 0x143, 0xc));
    return v;
}
constexpr int L_VT1 = L_CW, L_CT1 = L_CW + 2304;
constexpr int FA_SCR = 640;
template <bool IS_ML>
__device__ __forceinline__ void chunk_scan_item(Frame& F, int layer, int item) {
    const int tid = F.tid, lane = F.lane, w = F.wave, fr = lane & 15, fq = lane >> 4;
    LAS unsigned char* lds = F.lds;
    LAS float* fa = (LAS float*)(lds + L_FA);
    LAS float* cw = (LAS float*)(lds + L_CW);
    const int b = item >> 3, hg = (item >> 1) & 3, sl = item & 1;
    const int hd0 = IS_ML ? hg : hg * 4 + sl * 2;
    const int seq0 = ROW0 + b * PT;
    const int qcol = IS_ML ? C_Q + hg * 128 : 512 + hg * 128;
    const int kcol = IS_ML ? C_K + hg * 128 : hg * 128;
    const int vcol = IS_ML ? C_V + hg * 256 + sl * 128 : C_XBC + hd0 * 64;
    const int zcol = C_SZ + hd0 * 64;
    const int hw = IS_ML ? 0 : (w & 1);
    float fbias = 0.f, dtb = 0.f, aneg = 0.f, dskip = 0.f;
    if (IS_ML) fbias = inp(F, I_FBIAS)[layer * 4 + hg];
    else { const int hh = hd0 + (w & 1); dtb = inp(F, I_SDTB)[layer * 16 + hh]; aneg = -__expf(inp(F, I_SALOG)[layer * 16 + hh]); dskip = inp(F, I_SD)[layer * 16 + hh]; }
    if (!IS_ML) {
        const float* W = inp(F, I_SCW) + (size_t)layer * 4 * 2048; const float* Bv = inp(F, I_SCB) + (size_t)layer * 2048;
        for (int i = tid; i < 5 * 128; i += NTHR) { const int j = i >> 7, c = i & 127; cw[i] = (j < 4) ? W[j * 2048 + hd0 * 64 + c] : Bv[hd0 * 64 + c]; }
    }
    if (IS_ML) { for (int i = tid; i < 16 * LDT / 2; i += NTHR) ((LAS unsigned*)(lds + L_VT1))[i] = 0x3f803f80u; }
    if (tid == 0) fa[FA_SC + 2] = 0.f;
    f32x4 st[9];
#pragma unroll
    for (int i = 0; i < 9; ++i) st[i] = (f32x4){0.f, 0.f, 0.f, 0.f};
    v4u pq[2], pk[2], pv[2];
    v4u rx[2];
    float g0 = 0.f, g1 = 0.f;
#define SCAN_PREFETCH(PJ) do { \
        const int pr0 = b * PT + 64 * (PJ); \
        if (IS_ML) { \
_Pragma("unroll") \
            for (int i = 0; i < 2; ++i) { const int pc = tid + 512 * i, row = pc >> 4, c16 = pc & 15; const bf16* src = F.U + (size_t)(pr0 + row) * LDU; \
                pq[i] = *(const v4u*)(src + qcol + c16 * 8); pk[i] = *(const v4u*)(src + kcol + c16 * 8); pv[i] = *(const v4u*)(src + vcol + c16 * 8); } \
            if (w == 7) { const float* us = F.USM + (size_t)(pr0 + lane) * USMW; g0 = us[hg]; g1 = us[4 + hg]; } \
        } else { \
            const bf16* ub = F.U + (size_t)pr0 * LDU; const bf16* bb = F.XN + (size_t)pr0 * DM; \
_Pragma("unroll") \
            for (int i = 0; i < 2; ++i) { const int pc = tid + 512 * i, row = pc >> 4, c0 = (pc & 15) * 8; \
                pq[i] = *(const v4u*)(bb + row * DM + qcol + c0); pk[i] = *(const v4u*)(bb + row * DM + kcol + c0); rx[i] = *(const v4u*)(ub + row * LDU + vcol + c0); } \
            if (w >= 6) g0 = F.USM[(size_t)(pr0 + lane) * USMW + 8 + hd0 + (w - 6)]; \
        } \
    } while (0)
    SCAN_PREFETCH(0);
    __syncthreads();
    const int tid_outer = tid;
#if defined(DBG_TIMING) && DBG_TIMING == 4
    unsigned long long dd1 = 0, dd2 = 0, dd3 = 0, tt0 = 0, tt1 = 0, tt2 = 0, tt3 = 0;
#define CS_T(x) x = __builtin_amdgcn_s_memrealtime()
#else
#define CS_T(x) do { } while (0)
#endif
#if defined(DBG_TIMING) && DBG_TIMING == 5
    unsigned long long fd[8] = {0, 0, 0, 0, 0, 0, 0, 0}, fprev = 0;
#define FS_T(k) do { __builtin_amdgcn_sched_barrier(0); const unsigned long long _t = __builtin_amdgcn_s_memrealtime(); if ((k) >= 0) fd[(k) < 0 ? 0 : (k)] += _t - fprev; fprev = _t; __builtin_amdgcn_sched_barrier(0); } while (0)
#else
#define FS_T(k) do { } while (0)
#endif
    for (int j = 0; j < NCH; ++j) {
        CS_T(tt0); FS_T(-1);
        int tid_l = tid_outer; asm volatile("" : "+v"(tid_l));
        const int tid = tid_l, lane = tid & 63, fr = lane & 15, fq = lane >> 4;
        const int r0 = b * PT + 64 * j;
        {
#pragma unroll
            for (int i = 0; i < 8; ++i) { v2u o; o.x = pk2(st[i][0], st[i][1]); o.y = pk2(st[i][2], st[i][3]); *(LAS v2u*)(lds + L_CT + ((16 * i + fr) * LDQ + 16 * w + 4 * fq) * 2) = o; }
            if (IS_ML) { v2u o; o.x = pk2(st[8][0], st[8][1]); o.y = pk2(st[8][2], st[8][3]); *(LAS v2u*)(lds + L_CT1 + (fr * LDQ + 16 * w + 4 * fq) * 2) = o; }
        }
        if (IS_ML) {
            LAS bf16* vt = (LAS bf16*)(lds + L_VT);
#pragma unroll
            for (int i = 0; i < 2; ++i) { const int pc = tid + 512 * i, row = pc >> 4, c16 = pc & 15;
                *(LAS v4u*)(lds + L_QS + (row * LDQ + c16 * 8) * 2) = pq[i]; *(LAS v4u*)(lds + L_KS + (row * LDQ + c16 * 8) * 2) = pk[i];
                const v4u v = pv[i]; LAS bf16* vp = vt + (c16 * 8) * LDT + row;
                vp[0 * LDT] = (bf16)(v.x & 0xffff); vp[1 * LDT] = (bf16)(v.x >> 16); vp[2 * LDT] = (bf16)(v.y & 0xffff); vp[3 * LDT] = (bf16)(v.y >> 16);
                vp[4 * LDT] = (bf16)(v.z & 0xffff); vp[5 * LDT] = (bf16)(v.z >> 16); vp[6 * LDT] = (bf16)(v.w & 0xffff); vp[7 * LDT] = (bf16)(v.w >> 16); }
        } else {
            {
                const v4u zero4 = {0u, 0u, 0u, 0u};
#pragma unroll
                for (int i = 0; i < 2; ++i) { const int pc = tid + 512 * i, row = pc >> 4, c0 = (pc & 15) * 8;
                    *(LAS v4u*)(lds + L_QS + (row * LDQ + c0) * 2) = pq[i]; *(LAS v4u*)(lds + L_KS + (row * LDQ + c0) * 2) = pk[i];
                    *(LAS v4u*)(lds + L_RAW + ((3 + row) * RAWLD + c0) * 2) = (r0 + row >= seq0) ? rx[i] : zero4; }
                if (tid < 48) *(LAS v4u*)(lds + L_RAW + tid * 16) = (j == 0) ? zero4 : *(const LAS v4u*)(lds + L_TAIL + tid * 16);
            }
            LBAR();
            if (tid < 48) *(LAS v4u*)(lds + L_TAIL + tid * 16) = *(const LAS v4u*)(lds + L_RAW + 64 * RAWLD * 2 + tid * 16);
            {
                const int cg = tid & 15, seg = tid >> 4, c0 = cg * 8;
                float o[2][8];
#pragma unroll
                for (int q = 0; q < 2; ++q) {
                    f32x4 oa = *(const LAS f32x4*)(cw + 512 + c0), ob = *(const LAS f32x4*)(cw + 512 + c0 + 4);
#pragma unroll
                    for (int jj = 0; jj < 4; ++jj) { const v4u v = *(const LAS v4u*)(lds + L_RAW + ((seg * 2 + q + jj) * RAWLD + c0) * 2);
                        const f32x4 wa = *(const LAS f32x4*)(cw + jj * 128 + c0), wb = *(const LAS f32x4*)(cw + jj * 128 + c0 + 4);
                        oa[0] += wa[0] * bflo(v.x); oa[1] += wa[1] * bfhi(v.x); oa[2] += wa[2] * bflo(v.y); oa[3] += wa[3] * bfhi(v.y);
                        ob[0] += wb[0] * bflo(v.z); ob[1] += wb[1] * bfhi(v.z); ob[2] += wb[2] * bflo(v.w); ob[3] += wb[3] * bfhi(v.w); }
                    o[q][0] = siluf_(oa[0]); o[q][1] = siluf_(oa[1]); o[q][2] = siluf_(oa[2]); o[q][3] = siluf_(oa[3]); o[q][4] = siluf_(ob[0]); o[q][5] = siluf_(ob[1]); o[q][6] = siluf_(ob[2]); o[q][7] = siluf_(ob[3]);
                }
#pragma unroll
                for (int e = 0; e < 8; ++e) *(LAS unsigned*)(lds + L_VT + ((c0 + e) * LDT + seg * 2) * 2) = pk2(o[0][e], o[1][e]);
            }
        }
        if (IS_ML ? (w == 7) : (w >= 6)) {
            const int hh = IS_ML ? 0 : (w - 6);
            LAS float* fh = fa + hh * FA_HSTR;
            const bool valid = (r0 + lane) >= seq0;
            if (IS_ML) {
                const float mprev = fa[FA_SC + 2];
                const float li = valid ? g0 : -INFINITY;
                const float lf = valid ? logsigmoidf_(g1 + fbias) : 0.f;
                const float bc = wave_cumsum(lf);
                const float c = li - bc;
                const float M = fmaxf(mprev, wave_cummax(c));
                const float M63 = __builtin_bit_cast(float, __builtin_amdgcn_readlane(__builtin_bit_cast(int, M), 63)), b63 = __builtin_bit_cast(float, __builtin_amdgcn_readlane(__builtin_bit_cast(int, bc), 63));
                fh[FA_COLV + lane] = c; fh[FA_ROWV + lane] = M; fh[FA_INTER + lane] = __expf(mprev - M); fh[FA_KS + lane] = __expf(c - M63); fh[FA_CLAMP + lane] = __expf(-(bc + M));
                if (lane == 0) { fa[FA_SC + 0] = __expf(mprev - M63); fa[FA_SC + 2] = b63 + M63; }
            } else {
                const float dtbh = inp(F, I_SDTB)[layer * 16 + hd0 + hh], anh = -__expf(inp(F, I_SALOG)[layer * 16 + hd0 + hh]);
                const float dt = valid ? softplusf_(g0 + dtbh) : 0.f;
                const float cum = wave_cumsum(dt * anh);
                const float cl = __builtin_bit_cast(float, __builtin_amdgcn_readlane(__builtin_bit_cast(int, cum), 63));
                fh[FA_COLV + lane] = -cum + __logf(dt); fh[FA_ROWV + lane] = -cum; fh[FA_INTER + lane] = __expf(cum); fh[FA_KS + lane] = __expf(cl - cum) * dt;
                if (lane == 0) fa[FA_SC + hh] = __expf(cl);
            }
        }
        FS_T(0);
        LBAR();
        CS_T(tt1); FS_T(1);
        if (j + 1 < NCH) SCAN_PREFETCH(j + 1);
        {
            const int tt = w >> 1;
#pragma unroll
            for (int h2 = 0; h2 < 2; ++h2) { const int stl = (w & 1) * 2 + h2;
                f32x4 acc = {0.f, 0.f, 0.f, 0.f};
#pragma unroll
                for (int kk = 0; kk < 4; ++kk) acc = MFMA16(ldfrag(lds + L_QS, LDQ, 16 * tt + fr, 32 * kk + 8 * fq), ldfrag(lds + L_KS, LDQ, 16 * stl + fr, 32 * kk + 8 * fq), acc);
                const int sidx = 16 * stl + fr;
#pragma unroll
                for (int hh = 0; hh < (IS_ML ? 1 : 2); ++hh) {
                    const LAS float* fh = fa + hh * FA_HSTR; const float cv = fh[FA_COLV + sidx];
                    LAS bf16* ps = (LAS bf16*)(lds + L_PS + hh * 9216);
#pragma unroll
                    for (int r = 0; r < 4; ++r) { const int t = 16 * tt + 4 * fq + r;
                        float val = (sidx <= t) ? acc[r] * __expf(cv - fh[FA_ROWV + t]) : 0.f;
                        ps[t * LDT + sidx] = (bf16)f2bf(val); }
                }
            }
            __builtin_amdgcn_sched_barrier(0); FS_T(2);
            {
                const int sidx = tid & 63, dg = tid >> 6; const float sc = IS_ML ? fa[FA_KS + sidx] : 1.0f;
                const v4u k0 = *(const LAS v4u*)(lds + L_KS + (sidx * LDQ + dg * 16) * 2), k1 = *(const LAS v4u*)(lds + L_KS + (sidx * LDQ + dg * 16 + 8) * 2);
                LAS bf16* kt = (LAS bf16*)(lds + L_KT) + (dg * 16) * LDT + sidx;
                kt[0 * LDT] = (bf16)f2bf(bflo(k0.x) * sc); kt[1 * LDT] = (bf16)f2bf(bfhi(k0.x) * sc); kt[2 * LDT] = (bf16)f2bf(bflo(k0.y) * sc); kt[3 * LDT] = (bf16)f2bf(bfhi(k0.y) * sc);
                kt[4 * LDT] = (bf16)f2bf(bflo(k0.z) * sc); kt[5 * LDT] = (bf16)f2bf(bfhi(k0.z) * sc); kt[6 * LDT] = (bf16)f2bf(bflo(k0.w) * sc); kt[7 * LDT] = (bf16)f2bf(bfhi(k0.w) * sc);
                kt[8 * LDT] = (bf16)f2bf(bflo(k1.x) * sc); kt[9 * LDT] = (bf16)f2bf(bfhi(k1.x) * sc); kt[10 * LDT] = (bf16)f2bf(bflo(k1.y) * sc); kt[11 * LDT] = (bf16)f2bf(bfhi(k1.y) * sc);
                kt[12 * LDT] = (bf16)f2bf(bflo(k1.z) * sc); kt[13 * LDT] = (bf16)f2bf(bfhi(k1.z) * sc); kt[14 * LDT] = (bf16)f2bf(bflo(k1.w) * sc); kt[15 * LDT] = (bf16)f2bf(bfhi(k1.w) * sc);
            }
            __builtin_amdgcn_sched_barrier(0);
            if (!IS_ML) {
                const int c = tid >> 2, sq = tid & 3; const LAS float* ksp = fa + (c >> 6) * FA_HSTR + FA_KS + sq * 16;
                const v4u a0 = *(const LAS v4u*)(lds + L_VT + (c * LDT + sq * 16) * 2), a1 = *(const LAS v4u*)(lds + L_VT + (c * LDT + sq * 16 + 8) * 2);
                v4u o0, o1;
                o0.x = pk2(bflo(a0.x) * ksp[0], bfhi(a0.x) * ksp[1]); o0.y = pk2(bflo(a0.y) * ksp[2], bfhi(a0.y) * ksp[3]); o0.z = pk2(bflo(a0.z) * ksp[4], bfhi(a0.z) * ksp[5]); o0.w = pk2(bflo(a0.w) * ksp[6], bfhi(a0.w) * ksp[7]);
                o1.x = pk2(bflo(a1.x) * ksp[8], bfhi(a1.x) * ksp[9]); o1.y = pk2(bflo(a1.y) * ksp[10], bfhi(a1.y) * ksp[11]); o1.z = pk2(bflo(a1.z) * ksp[12], bfhi(a1.z) * ksp[13]); o1.w = pk2(bflo(a1.w) * ksp[14], bfhi(a1.w) * ksp[15]);
                *(LAS v4u*)(lds + L_V2 + (c * LDT + sq * 16) * 2) = o0; *(LAS v4u*)(lds + L_V2 + (c * LDT + sq * 16 + 8) * 2) = o1;
            }
        }
        FS_T(3);
        LBAR();
        CS_T(tt2); FS_T(4);
        {
            const int tt = w >> 1, vbase = (w & 1) * 4;
            const LAS float* fh = fa + hw * FA_HSTR;
            bf16x8 ap[2], aq[4];
#pragma unroll
            for (int kk = 0; kk < 2; ++kk) ap[kk] = ldfrag(lds + L_PS + hw * 9216, LDT, 16 * tt + fr, 32 * kk + 8 * fq);
#pragma unroll
            for (int kk = 0; kk < 4; ++kk) aq[kk] = ldfrag(lds + L_QS, LDQ, 16 * tt + fr, 32 * kk + 8 * fq);
            float itv[4], dnv[4];
#pragma unroll
            for (int r = 0; r < 4; ++r) { itv[r] = fh[FA_INTER + 16 * tt + 4 * fq + r]; dnv[r] = 0.f; }
            if (IS_ML) {
                f32x4 ad = {0.f, 0.f, 0.f, 0.f}, an = {0.f, 0.f, 0.f, 0.f};
#pragma unroll
                for (int kk = 0; kk < 2; ++kk) ad = MFMA16(ap[kk], ldfrag(lds + L_VT1, LDT, fr, 32 * kk + 8 * fq), ad);
#pragma unroll
                for (int kk = 0; kk < 4; ++kk) an = MFMA16(aq[kk], ldfrag(lds + L_CT1, LDQ, fr, 32 * kk + 8 * fq), an);
#pragma unroll
                for (int r = 0; r < 4; ++r) dnv[r] = 1.0f / fmaxf(fabsf(ad[r] + itv[r] * an[r]), fh[FA_CLAMP + 16 * tt + 4 * fq + r]);
            }
            bf16* orow = F.U + (size_t)(r0 + 16 * tt + 4 * fq) * LDU + (IS_ML ? vcol : zcol) + 16 * vbase + fr;
#pragma unroll
            for (int q = 0; q < 4; ++q) { const int vt2 = vbase + q;
                unsigned short zq[4] = {0, 0, 0, 0};
                if (!IS_ML) {
#pragma unroll
                    for (int r = 0; r < 4; ++r) zq[r] = orow[(size_t)r * LDU + 16 * q];
                }
                f32x4 apv = {0.f, 0.f, 0.f, 0.f}, aqc = {0.f, 0.f, 0.f, 0.f};
#pragma unroll
                for (int kk = 0; kk < 2; ++kk) apv = MFMA16(ap[kk], ldfrag(lds + L_VT, LDT, 16 * vt2 + fr, 32 * kk + 8 * fq), apv);
#pragma unroll
                for (int kk = 0; kk < 4; ++kk) aqc = MFMA16(aq[kk], ldfrag(lds + L_CT, LDQ, 16 * vt2 + fr, 32 * kk + 8 * fq), aqc);
                const int vv = 16 * vt2 + fr;
#pragma unroll
                for (int r = 0; r < 4; ++r) { const int t = 16 * tt + 4 * fq + r; const int row = r0 + t;
                    const float num = apv[r] + itv[r] * aqc[r];
                    if (row >= seq0) {
                        if (IS_ML) orow[(size_t)r * LDU + 16 * q] = (bf16)f2bf(num * dnv[r]);
                        else { const float xv = bf2f(((const LAS bf16*)(lds + L_VT))[vv * LDT + t]);
                            orow[(size_t)r * LDU + 16 * q] = (bf16)f2bf((num + dskip * xv) * siluf_(bf2f(zq[r]))); }
                    } }
                asm volatile("" ::: "memory"); __builtin_amdgcn_sched_barrier(0);
            }
            __builtin_amdgcn_sched_barrier(0); FS_T(5);
            const float wc0 = fa[FA_SC + 0], wc1 = IS_ML ? wc0 : fa[FA_SC + 1];
            bf16x8 ak[2];
#pragma unroll
            for (int kk = 0; kk < 2; ++kk) ak[kk] = ldfrag(lds + L_KT, LDT, 16 * w + fr, 32 * kk + 8 * fq);
#pragma unroll
            for (int i = 0; i < 8; ++i) { st[i] = st[i] * ((i < 4) ? wc0 : wc1);
#pragma unroll
                for (int kk = 0; kk < 2; ++kk) st[i] = MFMA16(ak[kk], ldfrag(lds + (IS_ML ? L_VT : L_V2), LDT, 16 * i + fr, 32 * kk + 8 * fq), st[i]); }
            if (IS_ML) { st[8] = st[8] * wc0;
#pragma unroll
                for (int kk = 0; kk < 2; ++kk) st[8] = MFMA16(ak[kk], ldfrag(lds + L_VT1, LDT, fr, 32 * kk + 8 * fq), st[8]); }
        }
        FS_T(6);
        LBAR();
        FS_T(7);
#if defined(DBG_TIMING) && DBG_TIMING == 4
        CS_T(tt3); dd1 += tt1 - tt0; dd2 += tt2 - tt1; dd3 += tt3 - tt2;
#endif
    }
#if defined(DBG_TIMING) && DBG_TIMING == 4
    if (layer == 0 && tid_outer == 0) { volatile LAS unsigned long long* tsl = (volatile LAS unsigned long long*)(F.lds + LDSCTL_OFF + 768); tsl[0] = 0; tsl[1] = dd1; tsl[2] = dd1 + dd2; tsl[3] = dd1 + dd2 + dd3; }
#endif
#if defined(DBG_TIMING) && DBG_TIMING == 5
    if (IS_ML && layer == 0 && tid_outer == 0) { volatile LAS unsigned long long* tsl = (volatile LAS unsigned long long*)(F.lds + LDSCTL_OFF + 768); unsigned long long a = 0; tsl[0] = 0;
#pragma unroll
        for (int k = 0; k < 8; ++k) { a += fd[k]; tsl[k + 1] = a; } }
#endif
#undef CS_T
#undef FS_T
    if (IS_ML) {
        float* pc = F.out + O_PC + (((size_t)(layer * BATCH + b) * 4 + hg) * 128) * 256 + sl * 128;
#pragma unroll
        for (int i = 0; i < 8; ++i)
#pragma unroll
            for (int r = 0; r < 4; ++r) pc[(size_t)(16 * w + 4 * fq + r) * 256 + 16 * i + fr] = st[i][r];
        if (sl == 0) { if (fr == 0) {
#pragma unroll
                for (int r = 0; r < 4; ++r) F.out[O_PN + ((size_t)(layer * BATCH + b) * 4 + hg) * 128 + 16 * w + 4 * fq + r] = st[8][r]; }
            if (tid == 0) F.out[O_PM + (layer * BATCH + b) * 4 + hg] = fa[FA_SC + 2]; }
    } else {
#pragma unroll
        for (int i = 0; i < 8; ++i) { const int hh = hd0 + (i >> 2), pcol = (i & 3) * 16 + fr;
            *(f32x4*)(F.out + O_PHS + (((size_t)(layer * BATCH + b) * 16 + hh) * 64 + pcol) * 128 + 16 * w + 4 * fq) = st[i]; }
    }
    __syncthreads();
}

#undef SCAN_PREFETCH
constexpr int LR_T = 192, LR_STEPS = 11;
constexpr int L_XB = 0, L_XF = 27648, L_AA = 76800, L_WA = 125952, L_WX = 135168, L_SA = 144384, L_SU = 146432, L_HP = 148480, L_LCW = 148992;
static_assert(LR_T * LR_STEPS == NCH * 64 && L_LCW + 5 * 64 * 4 <= LDSCTL_OFF, "LRU item geometry");
__device__ __forceinline__ void lru_prompt_item(Frame& F, int layer, int item) {
    const int tid = F.tid, w = F.wave;
    LAS unsigned char* lds = F.lds;
    const int b = item >> 4, blk = item & 15;
    const int seq0 = ROW0 + b * PT, ch0 = blk * 64;
    LAS float* xf = (LAS float*)(lds + L_XF); LAS float* aa = (LAS float*)(lds + L_AA);
    LAS float* sa = (LAS float*)(lds + L_SA); LAS float* su = (LAS float*)(lds + L_SU); LAS float* hp = (LAS float*)(lds + L_HP);
    {
#pragma unroll
        for (int i = 0; i < 2; ++i) { const int idx = tid + 512 * i, ax = idx >> 9, e = (idx >> 3) & 63, c = idx & 7;
            *(LAS v4u*)(lds + (ax ? L_WX : L_WA) + (e * LDT + c * 8) * 2) = *(const v4u*)(F.WLRU + ((((size_t)layer * 2 + ax) * 16 + blk) * 64 + e) * 64 + c * 8); }
    }
    if (tid < 128) hp[tid] = 0.f;
    const int cgc = tid & 7;
    LAS float* lcw = (LAS float*)(lds + L_LCW);
    if (tid < 320) { const int jj = tid >> 6, c = tid & 63; lcw[tid] = (jj < 4) ? inp(F, I_LCW)[(size_t)layer * 4 * 1024 + jj * 1024 + ch0 + c] : inp(F, I_LCB)[(size_t)layer * 1024 + ch0 + c]; }
    float gba[4], gbx[4], gsp[4];
#pragma unroll
    for (int et = 0; et < 4; ++et) { const int chn = ch0 + 16 * et + (tid & 15); gba[et] = inp(F, I_LBA)[layer * 1024 + chn]; gbx[et] = inp(F, I_LBX)[layer * 1024 + chn]; gsp[et] = softplusf_(-inp(F, I_LLAM)[layer * 1024 + chn]); }
    v4u pre[3][4];
#define LRU_PREFETCH(PJ) do { const bf16* ub = F.U + (size_t)(b * PT + LR_T * (PJ)) * LDU + C_LX + ch0 + cgc * 8; \
_Pragma("unroll") for (int i = 0; i < 3; ++i) { const int row = (tid + 512 * i) >> 3; \
_Pragma("unroll") for (int jj = 0; jj < 4; ++jj) pre[i][jj] = *(const v4u*)(ub + (row - 3 + jj) * LDU); } } while (0)
    LRU_PREFETCH(0);
    __syncthreads();
    const int tid_outer = tid;
    for (int j = 0; j < LR_STEPS; ++j) {
        int tid_l = tid_outer; asm volatile("" : "+v"(tid_l));
        const int tid = tid_l, lane = tid & 63, fr = lane & 15, fq = lane >> 4;
        const int r0 = b * PT + LR_T * j, cur = j & 1;
        {
            const v4u zero4 = {0u, 0u, 0u, 0u};
#pragma unroll
            for (int i = 0; i < 3; ++i) { const int row = (tid + 512 * i) >> 3;
                float acc[8];
                { const f32x4 ba = *(const LAS f32x4*)(lcw + 256 + cgc * 8), bb = *(const LAS f32x4*)(lcw + 256 + cgc * 8 + 4);
                  acc[0] = ba[0]; acc[1] = ba[1]; acc[2] = ba[2]; acc[3] = ba[3]; acc[4] = bb[0]; acc[5] = bb[1]; acc[6] = bb[2]; acc[7] = bb[3]; }
#pragma unroll
                for (int jj = 0; jj < 4; ++jj) { const v4u v = (r0 + row - 3 + jj >= seq0) ? pre[i][jj] : zero4;
                    const f32x4 wa = *(const LAS f32x4*)(lcw + jj * 64 + cgc * 8), wb = *(const LAS f32x4*)(lcw + jj * 64 + cgc * 8 + 4);
                    acc[0] += wa[0] * bflo(v.x); acc[1] += wa[1] * bfhi(v.x); acc[2] += wa[2] * bflo(v.y); acc[3] += wa[3] * bfhi(v.y);
                    acc[4] += wb[0] * bflo(v.z); acc[5] += wb[1] * bfhi(v.z); acc[6] += wb[2] * bflo(v.w); acc[7] += wb[3] * bfhi(v.w); }
                v4u pk; pk.x = pk2(acc[0], acc[1]); pk.y = pk2(acc[2], acc[3]); pk.z = pk2(acc[4], acc[5]); pk.w = pk2(acc[6], acc[7]);
                *(LAS v4u*)(lds + L_XB + (row * LDT + cgc * 8) * 2) = pk;
                *(LAS f32x4*)(xf + row * 64 + cgc * 8) = (f32x4){acc[0], acc[1], acc[2], acc[3]}; *(LAS f32x4*)(xf + row * 64 + cgc * 8 + 4) = (f32x4){acc[4], acc[5], acc[6], acc[7]}; }
        }
        LBAR();
        if (j + 1 < LR_STEPS) LRU_PREFETCH(j + 1);
        {
#pragma unroll
            for (int q = 0; q < 6; ++q) { const int tile = w * 6 + q, tt = tile >> 2, et = tile & 3;
                f32x4 ga = {0.f, 0.f, 0.f, 0.f}, gx = {0.f, 0.f, 0.f, 0.f};
#pragma unroll
                for (int kk = 0; kk < 2; ++kk) { const bf16x8 a = ldfrag(lds + L_XB, LDT, 16 * tt + fr, 32 * kk + 8 * fq);
                    ga = MFMA16(a, ldfrag(lds + L_WA, LDT, 16 * et + fr, 32 * kk + 8 * fq), ga); gx = MFMA16(a, ldfrag(lds + L_WX, LDT, 16 * et + fr, 32 * kk + 8 * fq), gx); }
                const float ba = (et == 0) ? gba[0] : (et == 1) ? gba[1] : (et == 2) ? gba[2] : gba[3], bx = (et == 0) ? gbx[0] : (et == 1) ? gbx[1] : (et == 2) ? gbx[2] : gbx[3];
                const float spl = (et == 0) ? gsp[0] : (et == 1) ? gsp[1] : (et == 2) ? gsp[2] : gsp[3];
#pragma unroll
                for (int r = 0; r < 4; ++r) { const int t = 16 * tt + 4 * fq + r; const bool valid = (r0 + t) >= seq0; const int ix = t * 64 + 16 * et + fr;
                    const float rg = sigmoidf_(ga[r] + ba), ig = sigmoidf_(gx[r] + bx);
                    const float la = -8.0f * rg * spl; const float av = __expf(la);
                    const float uv = sqrtf(fmaxf(1.0f - __expf(2.0f * la), 0.f)) * (ig * xf[ix]);
                    aa[ix] = valid ? av : 1.0f; xf[ix] = valid ? uv : 0.f; }
            }
        }
        LBAR();
        {
            const int e = tid & 63, seg = tid >> 6;
            const bf16* zb = F.U + (size_t)(r0 + seg * 24) * LDU + C_LZ + ch0 + e;
            unsigned short zv[24];
#pragma unroll
            for (int i = 0; i < 24; ++i) zv[i] = zb[(size_t)i * LDU];
            float A = 1.f, Ua = 0.f;
#pragma unroll
            for (int i = 0; i < 24; ++i) { const float a = aa[(seg * 24 + i) * 64 + e], u = xf[(seg * 24 + i) * 64 + e]; A = a * A; Ua = a * Ua + u; }
            sa[seg * 64 + e] = A; su[seg * 64 + e] = Ua;
            LBAR();
            float h = hp[cur * 64 + e];
            for (int s2 = 0; s2 < seg; ++s2) h = sa[s2 * 64 + e] * h + su[s2 * 64 + e];
            bf16* zo = F.U + (size_t)(r0 + seg * 24) * LDU + C_LZ + ch0 + e;
#pragma unroll
            for (int i = 0; i < 24; ++i) { h = aa[(seg * 24 + i) * 64 + e] * h + xf[(seg * 24 + i) * 64 + e];
                if (r0 + seg * 24 + i >= seq0) zo[(size_t)i * LDU] = (bf16)f2bf(h * siluf_(bf2f(zv[i]))); }
            if (seg == 7) hp[(cur ^ 1) * 64 + e] = h;
        }
        LBAR();
    }
#undef LRU_PREFETCH
    if (tid < 64) F.out[O_PHL + (size_t)(layer * BATCH + b) * 1024 + ch0 + tid] = hp[(LR_STEPS & 1) * 64 + tid];
    __syncthreads();
}

__device__ __forceinline__ float scan8_add(float x, int l8) {
#pragma unroll
    for (int o = 1; o < 8; o <<= 1) { const float t = __shfl_up(x, o, 8); if (l8 >= o) x += t; }
    return x;
}
__device__ __forceinline__ float scan8_max(float x, int l8) {
#pragma unroll
    for (int o = 1; o < 8; o <<= 1) { const float t = __shfl_up(x, o, 8); if (l8 >= o) x = fmaxf(x, t); }
    return x;
}
constexpr int S_QS = 0, S_KR = 4096, S_KW = 8192, S_NV = 12288, S_G = 12800, S_PM = 13312, S_QCS = 13568;
__device__ __forceinline__ void mlstm_sample_item(Frame& F, int layer, int item) {
    int tid_l = F.tid; asm volatile("" : "+v"(tid_l));
    const int tid = tid_l, lane = tid & 63, w = F.wave;
    const int b = item >> 2, hd = item & 3;
    LAS float* qs = (LAS float*)(F.lds + S_QS); LAS float* kr = (LAS float*)(F.lds + S_KR); LAS float* kw = (LAS float*)(F.lds + S_KW);
    LAS float* nv = (LAS float*)(F.lds + S_NV); LAS float* g = (LAS float*)(F.lds + S_G); LAS float* pm = (LAS float*)(F.lds + S_PM); LAS float* qcs = (LAS float*)(F.lds + S_QCS);
    const int row0 = SROW0 + b * DECS;
    const size_t sidx = (size_t)(layer * DECB + b) * 4 + hd;
    const float* c0 = inp(F, I_SC) + sidx * 128 * 256 + (size_t)w * 256 + 4 * lane; float* c1 = F.out + O_SC + sidx * 128 * 256 + (size_t)w * 256 + 4 * lane;
    f32x4 cv[4];
#pragma unroll
    for (int i = 0; i < 4; ++i) cv[i] = __builtin_nontemporal_load((const f32x4*)(c0 + (size_t)i * 8 * 256));
#pragma unroll
    for (int i = 0; i < 2; ++i) { const int idx = tid + 512 * i, t = idx >> 7, d = idx & 127; const bf16* ur = F.U + (size_t)(row0 + t) * LDU;
        qs[d * 8 + t] = bf2f(ur[C_Q + hd * 128 + d]); kr[d * 8 + t] = bf2f(ur[C_K + hd * 128 + d]); }
    if (tid < 128) nv[tid] = inp(F, I_SN)[sidx * 128 + tid];
    if (w == 7 && lane < 8) {
        const float* us = F.USM + (size_t)(row0 + lane) * USMW;
        const float m0 = inp(F, I_SM)[sidx];
        const float li = us[hd], lf = logsigmoidf_(us[4 + hd] + inp(F, I_FBIAS)[layer * 4 + hd]);
        const float bc = scan8_add(lf, lane), c = li - bc, M = fmaxf(m0, scan8_max(c, lane));
        const float M7 = __shfl(M, 7, 8), b7 = __shfl(bc, 7, 8);
        g[lane] = c; g[8 + lane] = M; g[16 + lane] = __expf(m0 - M); g[24 + lane] = __expf(c - M7); g[32 + lane] = __expf(-(bc + M));
        if (lane == 0) { g[56] = __expf(m0 - M7); g[57] = b7 + M7; }
    }
    float vv[8][4];
#pragma unroll
    for (int t = 0; t < 8; ++t) { const v2u x = *(const v2u*)(F.U + (size_t)(row0 + t) * LDU + C_V + hd * 256 + 4 * lane); vv[t][0] = bflo(x.x); vv[t][1] = bfhi(x.x); vv[t][2] = bflo(x.y); vv[t][3] = bfhi(x.y); }
    LBAR();
    if (w == 0) {
        const int t = lane >> 3, sx = lane & 7; float d = 0.f;
#pragma unroll 8
        for (int dd = 0; dd < 128; ++dd) d += qs[dd * 8 + t] * kr[dd * 8 + sx];
        float val = (sx <= t) ? d * __expf(g[sx] - g[8 + t]) : 0.f;
        pm[t * 8 + sx] = val;
        val += __shfl_xor(val, 1); val += __shfl_xor(val, 2); val += __shfl_xor(val, 4);
        if (sx == 0) g[40 + t] = val;
    } else if (w == 1) {
        const int t = lane >> 3, part = lane & 7; float d = 0.f;
#pragma unroll 8
        for (int dd = part * 16; dd < part * 16 + 16; ++dd) d += qs[dd * 8 + t] * nv[dd];
        d += __shfl_xor(d, 1); d += __shfl_xor(d, 2); d += __shfl_xor(d, 4);
        if (part == 0) g[48 + t] = d;
    }
#pragma unroll
    for (int i = 0; i < 2; ++i) { const int idx = tid + 512 * i; kw[idx] = kr[idx] * g[24 + (idx & 7)]; }
    LBAR();
    float qc[8][4];
#pragma unroll
    for (int t = 0; t < 8; ++t) { qc[t][0] = 0.f; qc[t][1] = 0.f; qc[t][2] = 0.f; qc[t][3] = 0.f; }
    const float wc = g[56];
    const float* cp = c0 + (size_t)4 * 8 * 256; float* op = c1; int dbase = w;
#pragma unroll 1
    for (int hb = 0; hb < 4; ++hb) {
        asm volatile("" : "+v"(cp), "+v"(op));
        f32x4 cn[4];
        if (hb < 3) {
#pragma unroll
            for (int i = 0; i < 4; ++i) cn[i] = __builtin_nontemporal_load((const f32x4*)(cp + (size_t)i * 8 * 256));
        }
#pragma unroll
        for (int i = 0; i < 4; ++i) { const int d = dbase + 8 * i;
            const f32x4 q0 = *(const LAS f32x4*)(qs + d * 8), q1 = *(const LAS f32x4*)(qs + d * 8 + 4), k0 = *(const LAS f32x4*)(kw + d * 8), k1 = *(const LAS f32x4*)(kw + d * 8 + 4);
            const f32x4 c = cv[i]; f32x4 o;
#pragma unroll
            for (int e = 0; e < 4; ++e) {
                qc[0][e] += q0[0] * c[e]; qc[1][e] += q0[1] * c[e]; qc[2][e] += q0[2] * c[e]; qc[3][e] += q0[3] * c[e];
                qc[4][e] += q1[0] * c[e]; qc[5][e] += q1[1] * c[e]; qc[6][e] += q1[2] * c[e]; qc[7][e] += q1[3] * c[e];
                o[e] = wc * c[e] + (k0[0] * vv[0][e] + k0[1] * vv[1][e] + k0[2] * vv[2][e] + k0[3] * vv[3][e]) + (k1[0] * vv[4][e] + k1[1] * vv[5][e] + k1[2] * vv[6][e] + k1[3] * vv[7][e]); }
            __builtin_nontemporal_store(o, (f32x4*)(op + (size_t)i * 8 * 256)); }
        if (hb < 3) {
#pragma unroll
            for (int i = 0; i < 4; ++i) cv[i] = cn[i];
        }
        cp += 4 * 8 * 256; op += 4 * 8 * 256; dbase += 32;
    }
#pragma unroll
    for (int t = 0; t < 8; ++t) *(LAS f32x4*)(qcs + (w * 8 + t) * 256 + 4 * lane) = (f32x4){qc[t][0], qc[t][1], qc[t][2], qc[t][3]};
    LBAR();
    {
        const int t = w; f32x4 QC = {0.f, 0.f, 0.f, 0.f};
#pragma unroll
        for (int w2 = 0; w2 < 8; ++w2) QC = QC + *(const LAS f32x4*)(qcs + (w2 * 8 + t) * 256 + 4 * lane);
        const float it = g[16 + t]; const float dinv = 1.0f / fmaxf(fabsf(g[40 + t] + it * g[48 + t]), g[32 + t]);
        float hv[4];
#pragma unroll
        for (int e = 0; e < 4; ++e) { float pv = 0.f;
#pragma unroll
            for (int sx = 0; sx < 8; ++sx) pv += pm[t * 8 + sx] * vv[sx][e];
            hv[e] = (pv + it * QC[e]) * dinv; }
        v2u o; o.x = pk2(hv[0], hv[1]); o.y = pk2(hv[2], hv[3]);
        *(v2u*)(F.U + (size_t)(row0 + t) * LDU + C_V + hd * 256 + 4 * lane) = o;
    }
    if (tid < 128) { float nn = g[56] * nv[tid];
#pragma unroll
        for (int sx = 0; sx < 8; ++sx) nn += kw[tid * 8 + sx];
        F.out[O_SN + sidx * 128 + tid] = nn; }
    if (tid == 0) F.out[O_SM + sidx] = g[57];
    LBAR();
}

constexpr int T_BC = 0, T_CC = 4096, T_G = 8192, T_XS = 8448, T_H = 16640, T_W = 17408, T_SL = 17664;
__device__ __forceinline__ float ssd_conv_sample(Frame& F, int layer, int b, int row0, int t, int ch, const float* W, const float* Bv) {
    float a = Bv[ch];
#pragma unroll
    for (int jj = 0; jj < 4; ++jj) { const int tp = t - 3 + jj;
        const float raw = (tp >= 0) ? bf2f(F.U[(size_t)(row0 + tp) * LDU + C_XBC + ch]) : inp(F, I_SCS)[((size_t)(layer * DECB + b) * 3 + (3 + tp)) * 2048 + ch];
        a += W[jj * 2048 + ch] * raw; }
    return siluf_(a);
}
__device__ __forceinline__ void ssd_sample_item(Frame& F, int layer, int item) {
    int tid_l = F.tid; asm volatile("" : "+v"(tid_l));
    const int tid = tid_l, lane = tid & 63, w = F.wave;
    const int b = item >> 2, grp = item & 3, row0 = SROW0 + b * DECS;
    LAS float* Bc = (LAS float*)(F.lds + T_BC); LAS float* Cc = (LAS float*)(F.lds + T_CC); LAS float* G = (LAS float*)(F.lds + T_G);
    LAS float* xsa = (LAS float*)(F.lds + T_XS); LAS float* hva = (LAS float*)(F.lds + T_H); LAS float* Wm = (LAS float*)(F.lds + T_W); LAS float* Sl = (LAS float*)(F.lds + T_SL);
    const size_t sbase = ((size_t)(layer * DECB + b) * 16 + grp * 4) * 64 * 128;
    const float* s0 = inp(F, I_SHS) + sbase; float* s1 = F.out + O_SHS + sbase;
    f32x4 sv[4];
#pragma unroll
    for (int i = 0; i < 4; ++i) sv[i] = __builtin_nontemporal_load((const f32x4*)(s0 + (size_t)(tid + 512 * i) * 4));
    const float* W = inp(F, I_SCW) + (size_t)layer * 4 * 2048; const float* Bv = inp(F, I_SCB) + (size_t)layer * 2048;
#pragma unroll 2
    for (int i = 0; i < 4; ++i) { const int idx = tid + 512 * i, which = idx >> 10, t = (idx >> 7) & 7, n = idx & 127;
        const float val = ssd_conv_sample(F, layer, b, row0, t, 1024 + which * 512 + grp * 128 + n, W, Bv);
        if (which) Cc[t * 128 + n] = val; else Bc[t * 128 + n] = val; }
#pragma unroll 2
    for (int i = 0; i < 4; ++i) { const int idx = tid + 512 * i, e4 = idx >> 9, t = (idx >> 6) & 7, pp = idx & 63;
        xsa[idx] = ssd_conv_sample(F, layer, b, row0, t, (grp * 4 + e4) * 64 + pp, W, Bv); }
    if (w == 7 && lane < 32) { const int e4 = lane >> 3, t = lane & 7, hd = grp * 4 + e4;
        const float dt = softplusf_(F.USM[(size_t)(row0 + t) * USMW + 8 + hd] + inp(F, I_SDTB)[layer * 16 + hd]);
        const float aneg = -__expf(inp(F, I_SALOG)[layer * 16 + hd]);
        const float cum = scan8_add(dt * aneg, t), cl = __shfl(cum, 7, 8);
        LAS float* hv = hva + e4 * 48;
        hv[t] = cum; hv[8 + t] = dt; hv[16 + t] = __expf(cum); hv[24 + t] = __expf(cl - cum) * dt;
        if (t == 0) hv[32] = __expf(cl);
    }
    LBAR();
    if (w == 0) { const int t = lane >> 3, sx = lane & 7; float d = 0.f;
#pragma unroll 8
        for (int n = 0; n < 128; ++n) d += Cc[t * 128 + n] * Bc[sx * 128 + n];
        G[t * 8 + sx] = d; }
    for (int e4 = 0; e4 < 4; ++e4) {
        const int hd = grp * 4 + e4;
        LAS float* xs = xsa + e4 * 512; LAS float* hv = hva + e4 * 48;
#pragma unroll
        for (int i = 0; i < 4; ++i) { const int idx4 = tid + 512 * i, pp = idx4 >> 5, n4 = idx4 & 31; LAS float* d = Sl + pp * 129 + n4 * 4; d[0] = sv[i][0]; d[1] = sv[i][1]; d[2] = sv[i][2]; d[3] = sv[i][3]; }
        LBAR();
        if (e4 < 3) {
#pragma unroll
            for (int i = 0; i < 4; ++i) sv[i] = __builtin_nontemporal_load((const f32x4*)(s0 + (size_t)(e4 + 1) * 8192 + (size_t)(tid + 512 * i) * 4));
        }
        if (w == 0) { const int t = lane >> 3, sx = lane & 7; Wm[t * 8 + sx] = (sx <= t) ? G[t * 8 + sx] * __expf(hv[t] - hv[sx]) * hv[8 + sx] : 0.f; }
        float ycs = 0.f;
        { const int t = tid >> 6, pp = tid & 63;
#pragma unroll 8
          for (int n = 0; n < 128; ++n) ycs += Cc[t * 128 + n] * Sl[pp * 129 + n]; }
        LBAR();
        { const int t = tid >> 6, pp = tid & 63; float y = hv[16 + t] * ycs;
#pragma unroll
          for (int sx = 0; sx < 8; ++sx) y += Wm[t * 8 + sx] * xs[sx * 64 + pp];
          bf16* zp = F.U + (size_t)(row0 + t) * LDU + C_SZ + hd * 64 + pp;
          *zp = (bf16)f2bf((y + inp(F, I_SD)[layer * 16 + hd] * xs[t * 64 + pp]) * siluf_(bf2f(*zp))); }
        { const int n4 = tid & 31, pq = tid >> 5; const float wc = hv[32]; f32x4 bn[8];
#pragma unroll
          for (int sx = 0; sx < 8; ++sx) bn[sx] = *(const LAS f32x4*)(Bc + sx * 128 + n4 * 4) * hv[24 + sx];
#pragma unroll
          for (int i = 0; i < 4; ++i) { const int pp = pq + 16 * i; const LAS float* sl = Sl + pp * 129 + n4 * 4;
              f32x4 sn = (f32x4){sl[0], sl[1], sl[2], sl[3]} * wc;
#pragma unroll
              for (int sx = 0; sx < 8; ++sx) sn = sn + bn[sx] * xs[sx * 64 + pp];
              __builtin_nontemporal_store(sn, (f32x4*)(s1 + (size_t)e4 * 8192 + pp * 128 + n4 * 4)); } }
        LBAR();
    }
}

__device__ __forceinline__ void lru_sample_item(Frame& F, int layer, int item) {
    int tid_l = F.tid; asm volatile("" : "+v"(tid_l));
    const int tid = tid_l;
    const int b = item >> 1, half = item & 1, ch = half * 512 + tid, row0 = SROW0 + b * DECS, blk = ch >> 6, e = ch & 63;
    LAS float* xcs = (LAS float*)F.lds;
    float xc[8];
    { const float* W = inp(F, I_LCW) + (size_t)layer * 4 * 1024; const float bias = inp(F, I_LCB)[layer * 1024 + ch];
      float raw[11];
#pragma unroll
      for (int i = 0; i < 3; ++i) raw[i] = inp(F, I_SCL)[((size_t)(layer * DECB + b) * 3 + i) * 1024 + ch];
#pragma unroll
      for (int t = 0; t < 8; ++t) raw[3 + t] = bf2f(F.U[(size_t)(row0 + t) * LDU + C_LX + ch]);
      const float w0 = W[ch], w1 = W[1024 + ch], w2 = W[2048 + ch], w3 = W[3072 + ch];
#pragma unroll
      for (int t = 0; t < 8; ++t) { xc[t] = bias + w0 * raw[t] + w1 * raw[t + 1] + w2 * raw[t + 2] + w3 * raw[t + 3]; xcs[t * 512 + tid] = xc[t]; } }
    __syncthreads();
    float ra[8], rx[8];
#pragma unroll
    for (int t = 0; t < 8; ++t) { ra[t] = 0.f; rx[t] = 0.f; }
    { const float* wa = inp(F, I_LWA) + ((size_t)layer * 16 + blk) * 4096 + e; const float* wx = inp(F, I_LWX) + ((size_t)layer * 16 + blk) * 4096 + e;
      const int xb = (tid & ~63);
      for (int d = 0; d < 64; ++d) { const float a = wa[d * 64], x = wx[d * 64];
#pragma unroll
          for (int t = 0; t < 8; ++t) { const float xv = xcs[t * 512 + xb + d]; ra[t] += xv * a; rx[t] += xv * x; } } }
    const float ba = inp(F, I_LBA)[layer * 1024 + ch], bx = inp(F, I_LBX)[layer * 1024 + ch], spl = softplusf_(-inp(F, I_LLAM)[layer * 1024 + ch]);
    float h = inp(F, I_SHL)[(size_t)(layer * DECB + b) * 1024 + ch];
#pragma unroll
    for (int t = 0; t < 8; ++t) { const float rg = sigmoidf_(ra[t] + ba), ig = sigmoidf_(rx[t] + bx); const float la = -8.0f * rg * spl;
        h = __expf(la) * h + sqrtf(fmaxf(1.0f - __expf(2.0f * la), 0.f)) * (ig * xc[t]);
        bf16* zp = F.U + (size_t)(row0 + t) * LDU + C_LZ + ch; *zp = (bf16)f2bf(h * siluf_(bf2f(*zp))); }
    F.out[O_SHL + (size_t)(layer * DECB + b) * 1024 + ch] = h;
    __syncthreads();
}

__device__ __forceinline__ void bc_conv_phase(Frame& F, int layer) {
    const float* W = inp(F, I_SCW) + (size_t)layer * 4 * 2048 + 1024; const float* Bv = inp(F, I_SCB) + (size_t)layer * 2048 + 1024;
    const int gt = F.vcu * NTHR + F.tid, NG = F.G * NTHR;
    for (int task = gt; task < BATCH * 516 * 128; task += NG) {
        const int cgi = task & 127, sg = task >> 7, b = sg / 516, seg = sg - b * 516, c0 = cgi * 8;
        const int seq0 = ROW0 + b * PT, rbase = seq0 + seg * 4;
        float wv[5][8];
#pragma unroll
        for (int jj = 0; jj < 4; ++jj) { const f32x4 a = *(const f32x4*)(W + jj * 2048 + c0), c = *(const f32x4*)(W + jj * 2048 + c0 + 4);
            wv[jj][0] = a[0]; wv[jj][1] = a[1]; wv[jj][2] = a[2]; wv[jj][3] = a[3]; wv[jj][4] = c[0]; wv[jj][5] = c[1]; wv[jj][6] = c[2]; wv[jj][7] = c[3]; }
        { const f32x4 a = *(const f32x4*)(Bv + c0), c = *(const f32x4*)(Bv + c0 + 4);
          wv[4][0] = a[0]; wv[4][1] = a[1]; wv[4][2] = a[2]; wv[4][3] = a[3]; wv[4][4] = c[0]; wv[4][5] = c[1]; wv[4][6] = c[2]; wv[4][7] = c[3]; }
        v4u rw[7];
#pragma unroll
        for (int rr = 0; rr < 7; ++rr) { const int row = rbase - 3 + rr; rw[rr] = (v4u){0u, 0u, 0u, 0u}; if (row >= seq0) rw[rr] = *(const v4u*)(F.U + (size_t)row * LDU + C_XBC + 1024 + c0); }
#pragma unroll
        for (int q = 0; q < 4; ++q) { float o[8];
#pragma unroll
            for (int e = 0; e < 8; ++e) o[e] = wv[4][e];
#pragma unroll
            for (int jj = 0; jj < 4; ++jj) { const v4u v = rw[q + jj];
                o[0] += wv[jj][0] * bflo(v.x); o[1] += wv[jj][1] * bfhi(v.x); o[2] += wv[jj][2] * bflo(v.y); o[3] += wv[jj][3] * bfhi(v.y);
                o[4] += wv[jj][4] * bflo(v.z); o[5] += wv[jj][5] * bfhi(v.z); o[6] += wv[jj][6] * bflo(v.w); o[7] += wv[jj][7] * bfhi(v.w); }
            v4u pkd; pkd.x = pk2(siluf_(o[0]), siluf_(o[1])); pkd.y = pk2(siluf_(o[2]), siluf_(o[3])); pkd.z = pk2(siluf_(o[4]), siluf_(o[5])); pkd.w = pk2(siluf_(o[6]), siluf_(o[7]));
            *(v4u*)(F.XN + (size_t)(rbase + q) * DM + c0) = pkd; }
    }
}
#if defined(DBG_TIMING) && DBG_TIMING == 2
#define DBG_STAMP(i) do { if (F.tid == 0) ((volatile LAS unsigned long long*)(F.lds + LDSCTL_OFF + 768))[i] = __builtin_amdgcn_s_memrealtime(); } while (0)
#else
#define DBG_STAMP(i) do { } while (0)
#endif
constexpr int CW_Q = 2048;
__device__ __forceinline__ void scan_phase(Frame& F, int layer) {
    if (layer == 0) DBG_STAMP(0);
    for (int it = F.vcu; it < 256; it += F.G) {
        if (it < 64) chunk_scan_item<true>(F, layer, it);
        else if (it < 128) chunk_scan_item<false>(F, layer, it - 64);
        else lru_prompt_item(F, layer, it - 128);
    }
    if (layer == 0) DBG_STAMP(1);
    volatile LAS int* qslot = (volatile LAS int*)(F.lds + LDSCTL_OFF + 64);
    for (;;) {
        __syncthreads();
        if (F.tid == 0) *qslot = (int)__hip_atomic_fetch_add((unsigned*)(F.ctl + CW_Q + 64 * layer), 1u, __ATOMIC_RELAXED, __HIP_MEMORY_SCOPE_AGENT);
        __syncthreads();
        const int q = *qslot;
        if (q >= DECB * 4 + DECB * 4 + DECB * 2) break;
        if (q < DECB * 4) mlstm_sample_item(F, layer, q);
        else if (q < DECB * 8) ssd_sample_item(F, layer, q - DECB * 4);
        else lru_sample_item(F, layer, q - DECB * 8);
    }
    if (layer == 0) DBG_STAMP(2);
}

__device__ __forceinline__ void gate_phase(Frame& F, int layer) {
    const int lane = F.lane;
    float g1[16], g2[16];
    { const float* p1 = inp(F, I_MLNG) + layer * 1024 + 16 * lane; const float* p2 = inp(F, I_SNG) + layer * 1024 + 16 * lane;
#pragma unroll
      for (int e = 0; e < 16; ++e) { g1[e] = p1[e]; g2[e] = p2[e]; } }
    const int gw = F.vcu * NWAVES + F.wave, NGW = F.G * NWAVES;
    for (int row = ROW0 + gw; row < RTOK; row += NGW) {
        bf16* ur = F.U + (size_t)row * LDU + 16 * lane;
        float h[16], o[16], z[16];
        unpack16(*(const v4u*)(ur + C_V), *(const v4u*)(ur + C_V + 8), h);
        unpack16(*(const v4u*)(ur + C_O), *(const v4u*)(ur + C_O + 8), o);
        unpack16(*(const v4u*)(ur + C_Z), *(const v4u*)(ur + C_Z + 8), z);
        float ss = 0.f;
#pragma unroll
        for (int e = 0; e < 16; ++e) ss += h[e] * h[e];
        ss += __shfl_xor(ss, 1); ss += __shfl_xor(ss, 2); ss += __shfl_xor(ss, 4); ss += __shfl_xor(ss, 8);
        const float rs = 1.0f / sqrtf(ss * (1.f / 256.f) + EPS);
#pragma unroll
        for (int e = 0; e < 16; ++e) h[e] = h[e] * rs * g1[e] * sigmoidf_(o[e]) * siluf_(z[e]);
        v4u a, b2; a.x = pk2(h[0], h[1]); a.y = pk2(h[2], h[3]); a.z = pk2(h[4], h[5]); a.w = pk2(h[6], h[7]); b2.x = pk2(h[8], h[9]); b2.y = pk2(h[10], h[11]); b2.z = pk2(h[12], h[13]); b2.w = pk2(h[14], h[15]);
        *(v4u*)(ur + C_V) = a; *(v4u*)(ur + C_V + 8) = b2;
        unpack16(*(const v4u*)(ur + C_SZ), *(const v4u*)(ur + C_SZ + 8), h);
        float s2 = 0.f;
#pragma unroll
        for (int e = 0; e < 16; ++e) s2 += h[e] * h[e];
        const float rs2 = 1.0f / sqrtf(wave_sum(s2) * (1.f / 1024.f) + EPS);
#pragma unroll
        for (int e = 0; e < 16; ++e) h[e] = h[e] * rs2 * g2[e];
        a.x = pk2(h[0], h[1]); a.y = pk2(h[2], h[3]); a.z = pk2(h[4], h[5]); a.w = pk2(h[6], h[7]); b2.x = pk2(h[8], h[9]); b2.y = pk2(h[10], h[11]); b2.z = pk2(h[12], h[13]); b2.w = pk2(h[14], h[15]);
        *(v4u*)(ur + C_SZ) = a; *(v4u*)(ur + C_SZ + 8) = b2;
    }
}
__device__ __forceinline__ void final_norm_phase(Frame& F) {
    const float* g = inp(F, I_FNG);
    f32x4 gv[4];
#pragma unroll
    for (int j = 0; j < 4; ++j) gv[j] = *(const f32x4*)(g + 4 * F.lane + 256 * j);
    const int gw = F.vcu * NWAVES + F.wave, NGW = F.G * NWAVES;
    for (int i = gw; i < BATCH * SEQ + SROWS; i += NGW) {
        float* xr = F.out + (size_t)i * DM;
        f32x4 v[4]; float s = 0.f;
#pragma unroll
        for (int j = 0; j < 4; ++j) { v[j] = *(const f32x4*)(xr + 4 * F.lane + 256 * j); s += (v[j].x * v[j].x + v[j].y * v[j].y) + (v[j].z * v[j].z + v[j].w * v[j].w); }
        const float rstd = 1.0f / sqrtf(wave_sum(s) * (1.f / DM) + EPS);
#pragma unroll
        for (int j = 0; j < 4; ++j) *(f32x4*)(xr + 4 * F.lane + 256 * j) = v[j] * rstd * gv[j];
    }
}

__global__ void __launch_bounds__(NTHR, 2) fwd_kernel(Args args) {
    extern __shared__ __attribute__((aligned(16))) unsigned char lds[];
    Frame F;
    F.lds = (LAS unsigned char*)lds;
    F.MISC = (volatile LAS unsigned*)(F.lds + MISC_OFF);
    F.tid = threadIdx.x; F.lane = F.tid & 63; F.wave = __builtin_amdgcn_readfirstlane(F.tid >> 6);
    F.G = gridDim.x; { const int bx = blockIdx.x; F.vcu = (F.G % 8 == 0) ? (bx % 8) * (F.G / 8) + bx / 8 : bx; }
    unsigned char* ws = args.ws; F.ws = ws; F.out = args.out;
    F.ctl = (gu32*)(ws + WS_CTL);
    F.U = (bf16*)(ws + WS_U); F.USM = (float*)(ws + WS_USM); F.XN = (bf16*)(ws + WS_XN); F.WIN = (bf16*)(ws + WS_WIN); F.WBR = (bf16*)(ws + WS_WBR);
    F.WOUT = (bf16*)(ws + WS_WOUT); F.WLRU = (bf16*)(ws + WS_WLRU); F.XAUX = (float*)(ws + WS_XAUX);
    for (int u = F.tid; u < (LDS_BYTES - LDSCTL_OFF) / 4; u += NTHR) ((LAS unsigned*)(F.lds + LDSCTL_OFF))[u] = 0u;
    __syncthreads();
    if (F.tid == 0) {
        LAS unsigned long long* t = (LAS unsigned long long*)(F.lds + PTR_OFF);
#pragma unroll
        for (int i = 0; i < 32; ++i) t[i] = (unsigned long long)args.in[i];
    }
    __syncthreads();
    XcdBarrier bar; bar.bar = (unsigned*)(F.ctl + CW_BAR); bar.x = 0; bar.st = nullptr;
    if (N_LAUNCHES == 1) bar = xcd_barrier_post((unsigned*)(F.ctl + CW_BAR), F.MISC + 8);
#define GRID_BAR() do { if (N_LAUNCHES == 1) xcd_barrier(bar); } while (0)
    const int lo = args.ph_lo, hi = args.ph_hi;
#define IN(k) (lo <= (k) && (k) < hi)
#ifdef DBG_TIMING
    volatile LAS unsigned long long* tsl = (volatile LAS unsigned long long*)(F.lds + LDSCTL_OFF + 768);
#if DBG_TIMING == 1
    GRID_BAR(); if (F.tid == 0) tsl[0] = __builtin_amdgcn_s_memrealtime();
#define SEAM(k) do { GRID_BAR(); if (F.tid == 0) tsl[(k) + 1] = __builtin_amdgcn_s_memrealtime(); } while (0)
#else
#define SEAM(k) do { GRID_BAR(); } while (0)
#endif
#else
#define SEAM(k) do { if (IN(k) && IN((k) + 1)) GRID_BAR(); } while (0)
#endif
    if (IN(0)) {
        LAS float* scr = (LAS float*)(F.lds + F.wave * 16384);
        const int gw = F.vcu * NWAVES + F.wave, NGW = F.G * NWAVES;
        for (int it = gw; it < WIN_ITEMS + WSQ_ITEMS + WLRU_ITEMS; it += NGW) {
            if (it < WIN_ITEMS) win_item(F, 0, it, scr);
            else if (it < WIN_ITEMS + WSQ_ITEMS) wsq_item(F, it - WIN_ITEMS, scr);
            else wlru_item(F, it - WIN_ITEMS - WSQ_ITEMS, scr);
        }
        __syncthreads();
        norm_rows(F, 0);
    }
    SEAM(0);
#define LAYER_PHASES(LYR, base) \
    if (IN((base) + 0)) { pg8::Gemm g{(const char*)F.XN, DM, (const char*)F.WIN, DM}; SchedIn S; S.T.init(R / 256, NBIG / 256, F.G, (int)blockIdx.x); \
        EpiU E{F.U}; pg8::gemm_phase<EpiU, SchedIn>(F.lds, g, S, E); } \
    SEAM((base) + 0); \
    if (IN((base) + 1)) { bc_conv_phase(F, LYR); conv_state_out(F, LYR); \
        if ((LYR) == 0) { __syncthreads(); LAS float* scr = (LAS float*)(F.lds + F.wave * 16384); const int gw = F.vcu * NWAVES + F.wave, NGW = F.G * NWAVES; \
            for (int it = gw; it < WIN_ITEMS; it += NGW) win_item(F, 1, it, scr); } } \
    SEAM((base) + 1); \
    if (IN((base) + 2)) { scan_phase(F, LYR); } \
    SEAM((base) + 2); \
    if (IN((base) + 3)) { gate_phase(F, LYR); } \
    SEAM((base) + 3); \
    if (IN((base) + 4)) { pg8::Gemm g{(const char*)F.U, LDU, (const char*)F.WBR, DM}; SchedBr S; S.T.init(R / 256, DM / 256, F.G, (int)blockIdx.x); S.layer = LYR; \
        EpiBr E{F.U, F.XN}; pg8::gemm_phase<EpiBr, SchedBr>(F.lds, g, S, E); } \
    SEAM((base) + 4); \
    if (IN((base) + 5)) { pg8::Gemm g{(const char*)F.XN, DM, (const char*)F.WOUT, DM}; SchedOut S; S.T.init(R / 256, DM / 256, F.G, (int)blockIdx.x); S.layer = LYR; \
        EpiOut E{&F, F.out, F.XAUX, LYR}; pg8::gemm_phase<EpiOut, SchedOut>(F.lds, g, S, E); } \
    SEAM((base) + 5);
    LAYER_PHASES(0, 1)
    if (IN(7)) norm_rows(F, 1);
    SEAM(7);
    LAYER_PHASES(1, 8)
    if (IN(14)) final_norm_phase(F);
#ifdef DBG_TIMING
    SEAM(14);
#if DBG_TIMING == 5
    if (blockIdx.x == 0) {
        __syncthreads();
        const size_t offs[8] = {O_PC, O_PN, O_PHL, O_PCL, O_PHS, O_PCS, O_SC, O_SN};
#pragma unroll
        for (int k = 0; k < 8; ++k) { const unsigned us = (unsigned)((tsl[k + 1] - tsl[k]) / 100ull);
            for (unsigned i = F.tid; i < us && i < 8000u; i += NTHR) ((unsigned*)F.out)[offs[k] + i] = 0xAAAAAAAAu; }
    }
#elif DBG_TIMING == 4
    if (blockIdx.x == 0 || blockIdx.x == 2) {
        __syncthreads();
        const size_t offs[6] = {O_PC, O_PN, O_PHL, O_PCL, O_PHS, O_PCS};
#pragma unroll
        for (int k = 0; k < 3; ++k) { const unsigned us = (unsigned)((tsl[k + 1] - tsl[k]) / 100ull);
            for (unsigned i = F.tid; i < us && i < 8000u; i += NTHR) ((unsigned*)F.out)[offs[(blockIdx.x / 2) * 3 + k] + i] = 0xAAAAAAAAu; }
    }
#elif DBG_TIMING == 2
    if (blockIdx.x == 0 || blockIdx.x == 2 || blockIdx.x == 4) {
        __syncthreads();
        const size_t offs[6] = {O_PC, O_PN, O_PHL, O_PCL, O_PHS, O_PCS};
#pragma unroll
        for (int k = 0; k < 2; ++k) { const unsigned us = (unsigned)((tsl[k + 1] - tsl[k]) / 100ull);
            for (unsigned i = F.tid; i < us && i < 8000u; i += NTHR) ((unsigned*)F.out)[offs[blockIdx.x + k] + i] = 0xAAAAAAAAu; }
    }
#else
    if (blockIdx.x == 0) {
        __syncthreads();
        const size_t offs[15] = {O_PC, O_PN, O_PHL, O_PCL, O_PHS, O_PCS, O_SC, O_SN, O_SHL, O_SCL, O_SHS, O_SCS, O_YP, O_YS, O_SM};
#pragma unroll
        for (int k = 0; k < 15; ++k) { const unsigned us = (unsigned)((tsl[k + 1] - tsl[k]) / 100ull);
            for (unsigned i = F.tid; i < us && i < (k == 14 ? 1000u : 8000u); i += NTHR) ((unsigned*)F.out)[offs[k] + i] = 0xAAAAAAAAu; }
    }
#endif
#endif
#undef IN
#undef SEAM
}

extern "C" void kernel_launch(void* const* d_in, const int* in_sizes, int n_in, void* d_out, int out_size, void* d_ws, size_t ws_size, hipStream_t stream) {
    static int grid = 0;
    if (grid == 0) {
        int dev = 0, cus = 0, per_cu = 0;
        if (hipGetDevice(&dev) != hipSuccess || hipDeviceGetAttribute(&cus, hipDeviceAttributeMultiprocessorCount, dev) != hipSuccess) { fprintf(stderr, "kernel_launch: device query failed\n"); grid = -1; return; }
        if (hipFuncSetAttribute((const void*)fwd_kernel, hipFuncAttributeMaxDynamicSharedMemorySize, LDS_BYTES) != hipSuccess) { fprintf(stderr, "kernel_launch: hipFuncSetAttribute failed\n"); grid = -1; return; }
        if (hipOccupancyMaxActiveBlocksPerMultiprocessor(&per_cu, (const void*)fwd_kernel, NTHR, LDS_BYTES) != hipSuccess || per_cu < 1) { fprintf(stderr, "kernel_launch: occupancy query says %d blocks per CU\n", per_cu); }
        (void)hipGetLastError();
        grid = cus;
        if (ws_size < WS_END) fprintf(stderr, "kernel_launch: workspace too small: %zu < %zu\n", ws_size, (size_t)WS_END);
        if (n_in != 32 || (size_t)out_size != O_END) fprintf(stderr, "kernel_launch: unexpected n_in %d / out_size %d (want 32 / %zu)\n", n_in, out_size, (size_t)O_END);
    }
    if (grid < 0) return;
    (void)in_sizes;
    if (hipMemsetAsync((char*)d_ws + WS_CTL, 0, CTL_ZERO_BYTES, stream) != hipSuccess) { fprintf(stderr, "kernel_launch: memset failed\n"); return; }
    Args a{};
    for (int i = 0; i < 32; ++i) a.in[i] = (const float*)d_in[i];
    a.out = (float*)d_out; a.ws = (unsigned char*)d_ws;
    for (int li = 0; li < N_LAUNCHES; ++li) {
        if (N_LAUNCHES == 1) { a.ph_lo = 0; a.ph_hi = N_PHASES; } else { a.ph_lo = li; a.ph_hi = li + 1; }
        a.li = li;
        hipLaunchKernelGGL(fwd_kernel, dim3(grid), dim3(NTHR), LDS_BYTES, stream, a);
        const hipError_t le = hipPeekAtLastError();
        if (le != hipSuccess) { fprintf(stderr, "kernel_launch: launch %d failed: %s\n", li, hipGetErrorName(le)); break; }
    }
}
```
